# Optimizing an MI355X kernel written in HIP

```python
import math
import jax, jax.numpy as jnp
from jax import lax
import numpy as np

D_MODEL = 1024
BATCH = 2
SEQ = 16384
DEPTH = 2
DEC_BATCH = 4
DEC_SEQ = 4096
PAST_LEN = 128

GRID_W = 64
HEAD_DIM = 64
NA_HEADS = 4
NA_WIN_ROWS = 8
NA_WIN_COLS = 16
NA_QCOLS = 16
NA_KCOLS = 32
DA_HEADS = 4
DA_CONFIGS = ((128, 1), (512, 4), (2048, 16))
DA_QBLOCK = 64
N_BUCKETS = 32
MAX_DISTANCE = 1024
HG_HEADS = 4
HG_DK = 128
HG_DV = 128
HG_CHUNK = 64

NA_WIDTH = NA_HEADS * HEAD_DIM
DA_WIDTH = DA_HEADS * HEAD_DIM
HG_FDIM = HG_HEADS * HG_DK
HG_WIDTH = HG_HEADS * HG_DV
MIX_WIDTH = NA_WIDTH + DA_WIDTH + HG_WIDTH
IN_SPLITS = (NA_WIDTH,) * 3 + (DA_WIDTH,) * 3 + (HG_FDIM,) * 3 + (HG_WIDTH,) * 2
N_IN = sum(IN_SPLITS)
D_FF = 2816
NORM_EPS = 1e-6
NEG_INF = -1e30

kernel_name = "hybrid_na_dilated_hgrn2_encoder"


def rmsnorm(x, g):
    x32 = x.astype(jnp.float32)
    y = x32 * lax.rsqrt(jnp.mean(x32 * x32, axis=-1, keepdims=True) + NORM_EPS)
    return (y * g.astype(jnp.float32)).astype(x.dtype)


def t5_bucket_np(rel):
    nb = N_BUCKETS // 2
    max_exact = nb // 2
    ret = np.where(rel > 0, nb, 0)
    n = np.abs(rel)
    large = max_exact + (np.log(np.maximum(n, 1) / max_exact)
                         / np.log(MAX_DISTANCE / max_exact) * (nb - max_exact)).astype(np.int32)
    large = np.minimum(large, nb - 1)
    return (ret + np.where(n < max_exact, n, large)).astype(np.int32)


def neighbourhood_attention(q, k, v, rpb):
    B, T, H, hd = q.shape
    rows = T // GRID_W
    wr = min(NA_WIN_ROWS, rows)
    ncb = GRID_W // NA_QCOLS
    r = np.arange(rows)
    r0 = np.clip(r - wr // 2, 0, rows - wr)
    ri = r0[:, None] + np.arange(wr)[None, :]
    c = np.arange(GRID_W).reshape(ncb, NA_QCOLS)
    c0 = np.clip(c - NA_WIN_COLS // 2, 0, GRID_W - NA_WIN_COLS)
    kb0 = np.clip(np.arange(ncb) * NA_QCOLS - NA_WIN_COLS // 2, 0, GRID_W - NA_KCOLS)
    ci = kb0[:, None] + np.arange(NA_KCOLS)[None, :]
    col_ok = (ci[:, None, :] >= c0[:, :, None]) & (ci[:, None, :] < c0[:, :, None] + NA_WIN_COLS)
    dr = ri - r[:, None] + NA_WIN_ROWS - 1
    dc = np.clip(ci[:, None, :] - c[:, :, None], -(NA_WIN_COLS - 1), NA_WIN_COLS - 1) + NA_WIN_COLS - 1
    bias = rpb[:, dr[:, None, None, :, None], dc[None, :, :, None, :]].astype(jnp.float32)
    bias = jnp.where(col_ok[None, None, :, :, None, :], bias, NEG_INF)
    qg = q.reshape(B, rows, ncb, NA_QCOLS, H, hd)
    rsel = ri[:, :, None, None]
    csel = ci[None, None, :, :]
    kg = k.reshape(B, rows, GRID_W, H, hd)[:, rsel, csel]
    vg = v.reshape(B, rows, GRID_W, H, hd)[:, rsel, csel]
    s = jnp.einsum('brnqhd,brwnkhd->bhrnqwk', qg, kg).astype(jnp.float32) + bias[None]
    p = jax.nn.softmax(s.reshape(s.shape[:5] + (-1,)), axis=-1).reshape(s.shape).astype(v.dtype)
    o = jnp.einsum('bhrnqwk,brwnkhd->brnqhd', p, vg)
    return o.reshape(B, T, H * hd).astype(jnp.float32)


def dilated_branch(q, k, v, bias_table, window, dilation):
    B, T, H, hd = q.shape
    d = dilation
    L = T // d
    hw = window // (2 * d)
    nblk = -(-L // DA_QBLOCK)
    lp = nblk * DA_QBLOCK
    kb = DA_QBLOCK + 2 * hw

    def to_sub(x):
        return x.reshape(B, L, d, H, hd).transpose(0, 2, 3, 1, 4).reshape(B * d, H, L, hd)

    qs = jnp.pad(to_sub(q), ((0, 0), (0, 0), (0, lp - L), (0, 0))).reshape(B * d, H, nblk, DA_QBLOCK, hd)
    kidx = np.arange(nblk)[:, None] * DA_QBLOCK + np.arange(kb)[None, :]
    kpad = ((0, 0), (0, 0), (hw, lp - L + hw), (0, 0))
    ks = jnp.pad(to_sub(k), kpad)[:, :, kidx]
    vs = jnp.pad(to_sub(v), kpad)[:, :, kidx]
    rel = np.arange(kb)[None, :] - np.arange(DA_QBLOCK)[:, None] - hw
    pos = kidx - hw
    ok = (np.abs(rel) <= hw)[None] & ((pos >= 0) & (pos < L))[:, None, :]
    bias = bias_table[t5_bucket_np(rel * d)].transpose(2, 0, 1).astype(jnp.float32)
    s = jnp.einsum('zhcqd,zhckd->zhcqk', qs, ks).astype(jnp.float32) + bias[None, :, None]
    s = jnp.where(ok[None, None], s, NEG_INF)
    lse = jax.nn.logsumexp(s, axis=-1)
    p = jnp.exp(s - lse[..., None]).astype(v.dtype)
    o = jnp.einsum('zhcqk,zhckd->zhcqd', p, vs).reshape(B * d, H, lp, hd)[:, :, :L]
    o = o.reshape(B, d, H, L, hd).transpose(0, 3, 1, 2, 4).reshape(B, T, H, hd)
    lse = lse.reshape(B * d, H, lp)[:, :, :L].reshape(B, d, H, L).transpose(0, 3, 1, 2).reshape(B, T, H)
    return o.astype(jnp.float32), lse


def dilated_attention(q, k, v, bias_table):
    outs, lses = [], []
    for window, dilation in DA_CONFIGS:
        o, lse = dilated_branch(q, k, v, bias_table, window, dilation)
        outs.append(o)
        lses.append(lse)
    w = jax.nn.softmax(jnp.stack(lses), axis=0)
    o = jnp.sum(w[..., None] * jnp.stack(outs), axis=0)
    B, T = q.shape[:2]
    return o.reshape(B, T, DA_WIDTH)


def hgrn_lower_bounds(lb_logits):
    p = jax.nn.softmax(lb_logits.astype(jnp.float32), axis=1)
    c = jnp.cumsum(p, axis=1)
    return c - c[:, :1]


def gla_chunk_scan(q, k, v, logf):
    B, T, H, dk = q.shape
    dv = v.shape[-1]
    C = HG_CHUNK
    nc = T // C

    def chunks(x):
        return x.reshape(B, nc, C, H, x.shape[-1]).transpose(1, 0, 3, 2, 4)

    tri = np.tril(np.ones((C, C), dtype=bool))[:, :, None]

    def step(S, inp):
        qc, kc, vc, gc = inp
        b = jnp.cumsum(gc, axis=-2)
        dec = jnp.exp(jnp.where(tri, b[..., :, None, :] - b[..., None, :, :], -jnp.inf))
        attn = jnp.einsum('bhtk,bhsk,bhtsk->bhts', qc, kc, dec)
        o = jnp.einsum('bhts,bhsv->bhtv', attn, vc) + jnp.einsum('bhtk,bhkv->bhtv', qc * jnp.exp(b), S)
        b_last = b[..., -1:, :]
        S = jnp.exp(b_last[..., 0, :])[..., None] * S + jnp.einsum('bhsk,bhsv->bhkv', kc * jnp.exp(b_last - b), vc)
        return S, o

    S0 = jnp.zeros((B, H, dk, dv), jnp.float32)
    _, o = lax.scan(step, S0, (chunks(q), chunks(k), chunks(v), chunks(logf)))
    return o.transpose(1, 0, 3, 2, 4).reshape(B, T, H, dv)


def hgrn2_mixer(cq, cff, cfb, ci, cg, lb_f, lb_b, norm_g):
    B, T, _ = cq.shape
    q = jax.nn.silu(cq.astype(jnp.float32)).reshape(B, T, HG_HEADS, HG_DK)
    v = ci.astype(jnp.float32).reshape(B, T, HG_HEADS, HG_DV)

    def gates(z, lb):
        z = z.astype(jnp.float32).reshape(B, T, HG_HEADS, HG_DK)
        lb = lb.reshape(HG_HEADS, HG_DK)
        logf = jnp.logaddexp(jnp.log(lb), jnp.log1p(-lb) + jax.nn.log_sigmoid(z))
        kk = (1.0 - lb) * jax.nn.sigmoid(-z)
        return logf, kk

    lf_f, k_f = gates(cff, lb_f)
    lf_b, k_b = gates(cfb, lb_b)
    o_f = gla_chunk_scan(q, k_f, v, lf_f)
    rev = lambda a: jnp.flip(a, axis=1)
    o_b = rev(gla_chunk_scan(rev(q), rev(k_b), rev(v), rev(lf_b)))
    o = rmsnorm(o_f + o_b, norm_g) * jax.nn.silu(cg.astype(jnp.float32)).reshape(B, T, HG_HEADS, HG_DV)
    return o.reshape(B, T, HG_WIDTH)


def encoder_layer(x, ln_mix_g, w_in, na_q_g, na_k_g, na_rpb, da_q_g, da_k_g, t5_bias,
                  lb_f, lb_b, hg_norm_g, w_out, ln_ffn_g, w_up, conv_w, conv_b, w_down):
    B, T, _ = x.shape
    scale = HEAD_DIM ** -0.5
    h = rmsnorm(x, ln_mix_g)
    proj = h @ w_in
    (aq, ak, av, bq, bk, bv, cq, cff, cfb, ci, cg) = jnp.split(proj, np.cumsum(IN_SPLITS)[:-1].tolist(), axis=-1)
    heads = lambda a, n: a.reshape(B, T, n, HEAD_DIM)
    qa = rmsnorm(heads(aq, NA_HEADS), na_q_g) * scale
    ka = rmsnorm(heads(ak, NA_HEADS), na_k_g)
    o_a = neighbourhood_attention(qa, ka, heads(av, NA_HEADS), na_rpb)
    qb = rmsnorm(heads(bq, DA_HEADS), da_q_g) * scale
    kb = rmsnorm(heads(bk, DA_HEADS), da_k_g)
    o_b = dilated_attention(qb, kb, heads(bv, DA_HEADS), t5_bias)
    o_c = hgrn2_mixer(cq, cff, cfb, ci, cg, lb_f, lb_b, hg_norm_g)
    mix = jnp.concatenate([o_a, o_b, o_c], axis=-1).astype(x.dtype) @ w_out
    x = x + mix.astype(x.dtype)
    h = rmsnorm(x, ln_ffn_g)
    gate, up = jnp.split(h @ w_up, 2, axis=-1)
    gp = jnp.pad(gate, ((0, 0), (1, 1), (0, 0)))
    gate = gp[:, :-2] * conv_w[0] + gp[:, 1:-1] * conv_w[1] + gp[:, 2:] * conv_w[2] + conv_b
    y = (jax.nn.gelu(gate) * up) @ w_down
    return x + y.astype(x.dtype)


def setup_inputs(seed: int = 0) -> dict:
    key = jax.random.key(seed)
    ks = jax.random.split(key, 20)
    f32 = jnp.float32
    nrm = lambda k, shape, s: jax.random.normal(k, shape, f32) * s
    return {
        "x_prompt": nrm(ks[0], (BATCH, SEQ, D_MODEL), 1.0),
        "x_sample": nrm(ks[1], (DEC_BATCH, DEC_SEQ, D_MODEL), 1.0),
        "ln_mix_g": 1.0 + nrm(ks[2], (DEPTH, D_MODEL), 0.1),
        "w_in": nrm(ks[3], (DEPTH, D_MODEL, N_IN), D_MODEL ** -0.5),
        "na_q_g": 1.0 + nrm(ks[4], (DEPTH, HEAD_DIM), 0.1),
        "na_k_g": 1.0 + nrm(ks[5], (DEPTH, HEAD_DIM), 0.1),
        "na_rpb": nrm(ks[6], (DEPTH, NA_HEADS, 2 * NA_WIN_ROWS - 1, 2 * NA_WIN_COLS - 1), 0.5),
        "da_q_g": 1.0 + nrm(ks[7], (DEPTH, HEAD_DIM), 0.1),
        "da_k_g": 1.0 + nrm(ks[8], (DEPTH, HEAD_DIM), 0.1),
        "t5_bias": nrm(ks[9], (N_BUCKETS, DA_HEADS), 0.5),
        "hg_lb_logits": nrm(ks[10], (2, DEPTH, HG_FDIM), 1.0),
        "hg_norm_g": 1.0 + nrm(ks[11], (DEPTH, HG_DV), 0.1),
        "w_out": nrm(ks[12], (DEPTH, MIX_WIDTH, D_MODEL), MIX_WIDTH ** -0.5),
        "ln_ffn_g": 1.0 + nrm(ks[13], (DEPTH, D_MODEL), 0.1),
        "w_up": nrm(ks[14], (DEPTH, D_MODEL, 2 * D_FF), D_MODEL ** -0.5),
        "conv_w": nrm(ks[15], (DEPTH, 3, D_FF), 3 ** -0.5),
        "conv_b": nrm(ks[16], (DEPTH, D_FF), 0.01),
        "w_down": nrm(ks[17], (DEPTH, D_FF, D_MODEL), D_FF ** -0.5),
    }


def reference(x_prompt, x_sample, ln_mix_g, w_in, na_q_g, na_k_g, na_rpb, da_q_g, da_k_g, t5_bias,
              hg_lb_logits, hg_norm_g, w_out, ln_ffn_g, w_up, conv_w, conv_b, w_down):
    lb = hgrn_lower_bounds(hg_lb_logits)

    def trunk(x):
        for l in range(DEPTH):
            x = encoder_layer(x, ln_mix_g[l], w_in[l], na_q_g[l], na_k_g[l], na_rpb[l],
                              da_q_g[l], da_k_g[l], t5_bias, lb[0, l], lb[1, l], hg_norm_g[l],
                              w_out[l], ln_ffn_g[l], w_up[l], conv_w[l], conv_b[l], w_down[l])
        return x

    y_prompt = trunk(x_prompt)
    y_sample = trunk(x_sample)
    return (y_prompt, y_sample)
```

```cpp
#include <hip/hip_runtime.h>
#include <hip/hip_cooperative_groups.h>
#include <cstdio>
#include <cstdint>
namespace cg = cooperative_groups;
namespace pg8 {
#define PG8_LAS __attribute__((address_space(3)))
typedef unsigned short bf16_t;
typedef short bf16x8 __attribute__((ext_vector_type(8)));
typedef float f32x4 __attribute__((ext_vector_type(4)));
typedef unsigned u32x4 __attribute__((ext_vector_type(4)));
constexpr int BM = 256, BK = 64, HALF = 128, HTB = HALF * BK * 2  , STAGE_BYTES = 8 * HTB, NXCD = 8, WGM = 8;

__host__ __device__ __forceinline__ int lds_byte(int r, int c) { const int st = (r >> 4) * 2 + (c >> 5), rr = r & 15, cc = c & 31, ob = rr * 64 + cc * 2; return st * 1024 + (ob ^ (((ob >> 9) & 1) << 5)); }
__host__ __device__ __forceinline__ void stage_rc(int b, int& R, int& C) { const int st = b / 1024, sb = b % 1024, swz = sb ^ (((sb >> 9) & 1) << 5); R = (st >> 1) * 16 + swz / 64; C = (st & 1) * 32 + (swz % 64) / 2; }
__host__ __device__ __forceinline__ int perm32(int rho) { const int n = rho >> 4, i = rho & 15; return 8 * (i >> 2) + 4 * n + (i & 3); }

struct Unit { int pm, pn; };
struct Gemm { const bf16_t* A; const bf16_t* Bt; int M, N, K; int a_rows; };

struct StaticOrder {
    int nM, nN, nwg, G, c;
    __host__ __device__ void init(int M, int N, int G_, int c_) { nM = M / BM; nN = N / BM; nwg = nM * nN; G = G_; c = c_; }
    __host__ __device__ bool next(int i, Unit& u) const {
        const long L = (long)i * G + c; if (L >= nwg) return false;
        int wgid = (int)L; { const int q = nwg / NXCD, r = nwg % NXCD, xcd = wgid % NXCD, off = wgid / NXCD; wgid = (xcd < r ? xcd * (q + 1) : r * (q + 1) + (xcd - r) * q) + off; }
        const int nig = WGM * nN, gid = wgid / nig, fm = gid * WGM, gsz = (nM - fm) < WGM ? (nM - fm) : WGM;
        u.pm = fm + ((wgid % nig) % gsz); u.pn = (wgid % nig) / gsz; return true;
    }
    __device__ __forceinline__ void a_ready(const Unit&) const {}
    __device__ __forceinline__ void done(const Unit&) const {}
};

typedef __bf16 bf2_t __attribute__((ext_vector_type(2)));
typedef float f32x2_t __attribute__((ext_vector_type(2)));
__device__ __forceinline__ unsigned cvt_pk_bf16(float lo, float hi) { const f32x2_t v = {lo, hi}; return __builtin_bit_cast(unsigned, __builtin_convertvector(v, bf2_t)); }
struct EpiBf16S {
    static constexpr bool PERM = true, AFTER_DRAIN = false;
    bf16_t* O; int ldc;
    __device__ __forceinline__ void operator()(const f32x4 (&acc)[2][2][4][2], const Unit& u, int wr, int wc, int fr, int fq) const {
        const int row0 = u.pm * BM + wr * 64 + fr, col0 = u.pn * BM + wc * 32 + 8 * fq;
#pragma unroll
        for (int ai = 0; ai < 2; ++ai)
#pragma unroll
            for (int m = 0; m < 4; ++m) { bf16_t* rowp = O + (size_t)(row0 + ai * HALF + m * 16) * ldc + col0;
#pragma unroll
                for (int bj = 0; bj < 2; ++bj) { const f32x4 v0 = acc[ai][bj][m][0], v1 = acc[ai][bj][m][1];
                    u32x4 w; w.x = cvt_pk_bf16(v0[0], v0[1]); w.y = cvt_pk_bf16(v0[2], v0[3]); w.z = cvt_pk_bf16(v1[0], v1[1]); w.w = cvt_pk_bf16(v1[2], v1[3]);
                    *(u32x4*)(rowp + bj * HALF) = w; } }
    }
};
struct EpiRes {
    static constexpr bool PERM = false, AFTER_DRAIN = false;
    const float* res; float* out; int ldc;
    __device__ __forceinline__ void operator()(const f32x4 (&acc)[2][2][4][2], const Unit& u, int wr, int wc, int fr, int fq) const {
        const int row0 = u.pm * BM + wr * 64 + fr, col0 = u.pn * BM + wc * 32 + 4 * fq;
#pragma unroll
        for (int ai = 0; ai < 2; ++ai)
#pragma unroll
            for (int m = 0; m < 4; ++m) { const size_t off = (size_t)(row0 + ai * HALF + m * 16) * ldc + col0;
#pragma unroll
                for (int bj = 0; bj < 2; ++bj)
#pragma unroll
                    for (int n = 0; n < 2; ++n) { const f32x4 r = *(const f32x4*)(res + off + bj * HALF + n * 16); *(f32x4*)(out + off + bj * HALF + n * 16) = r + acc[ai][bj][m][n]; } }
    }
};

__device__ __forceinline__ float row_rstd(const float* slots, int row, int ncols, float eps) { const f32x4 v = *(const f32x4*)(slots + (size_t)row * 4); return rsqrtf(((v[0] + v[1]) + (v[2] + v[3])) * (1.0f / ncols) + eps); }
struct EpiIn {
    static constexpr bool PERM = true, AFTER_DRAIN = false;
    bf16_t* O; int ldc; const float* slots; int use_rs; const float* gains[4]; PG8_LAS float* xch;
    __device__ __forceinline__ void operator()(const f32x4 (&acc)[2][2][4][2], const Unit& u, int wr, int wc, int fr, int fq) const {
        const int row0 = u.pm * BM + wr * 64 + fr, col0 = u.pn * BM + wc * 32 + 8 * fq;
        const int kind = u.pn == 0 ? 0 : u.pn == 1 ? 1 : u.pn == 3 ? 2 : u.pn == 4 ? 3 : -1;
        float rs[2][4];
        { const int tix = (wr * 4 + wc) * 64 + fq * 16 + fr;
          if (tix < 256) xch[2048 + tix] = use_rs ? row_rstd(slots, u.pm * BM + tix, 1024, 1e-6f) : 1.0f;
          asm volatile("s_waitcnt lgkmcnt(0)" ::: "memory"); __builtin_amdgcn_s_barrier(); asm volatile("" ::: "memory"); }
#pragma unroll
        for (int ai = 0; ai < 2; ++ai)
#pragma unroll
            for (int m = 0; m < 4; ++m) rs[ai][m] = xch[2048 + ai * HALF + wr * 64 + m * 16 + fr];
        if (kind >= 0) {
#pragma unroll
            for (int ai = 0; ai < 2; ++ai)
#pragma unroll
                for (int m = 0; m < 4; ++m)
#pragma unroll
                    for (int bj = 0; bj < 2; ++bj) { float s = 0.f;
#pragma unroll
                        for (int n = 0; n < 2; ++n)
#pragma unroll
                            for (int e = 0; e < 4; ++e) { const float v = acc[ai][bj][m][n][e] * rs[ai][m]; s += v * v; }
                        s += __shfl_xor(s, 16); s += __shfl_xor(s, 32);
                        if (fq == 0) xch[((ai * HALF + wr * 64 + m * 16 + fr) * 2 + bj) * 4 + wc] = s; }
            asm volatile("s_waitcnt lgkmcnt(0)" ::: "memory"); __builtin_amdgcn_s_barrier(); asm volatile("" ::: "memory");
            const float* gp = (kind == 0 ? gains[0] : kind == 1 ? gains[1] : kind == 2 ? gains[2] : gains[3]) + (wc & 1) * 32 + 8 * fq; const f32x4 g0 = *(const f32x4*)gp, g1 = *(const f32x4*)(gp + 4);
            const float qs = (kind & 1) ? 1.0f : 0.125f;
#pragma unroll
            for (int ai = 0; ai < 2; ++ai)
#pragma unroll
                for (int m = 0; m < 4; ++m) { bf16_t* rowp = O + (size_t)(row0 + ai * HALF + m * 16) * ldc + col0;
#pragma unroll
                    for (int bj = 0; bj < 2; ++bj) { const PG8_LAS float* xp = xch + ((ai * HALF + wr * 64 + m * 16 + fr) * 2 + bj) * 4 + (wc & 2);
                        const float tot = xp[0] + xp[1]; const float r = rsqrtf(tot * (1.0f / 64.0f) + 1e-6f) * qs * rs[ai][m];
                        const f32x4 v0 = acc[ai][bj][m][0] * r * g0, v1 = acc[ai][bj][m][1] * r * g1;
                        u32x4 w; w.x = cvt_pk_bf16(v0[0], v0[1]); w.y = cvt_pk_bf16(v0[2], v0[3]); w.z = cvt_pk_bf16(v1[0], v1[1]); w.w = cvt_pk_bf16(v1[2], v1[3]);
                        *(u32x4*)(rowp + bj * HALF) = w; } }
        } else {
#pragma unroll
            for (int ai = 0; ai < 2; ++ai)
#pragma unroll
                for (int m = 0; m < 4; ++m) { bf16_t* rowp = O + (size_t)(row0 + ai * HALF + m * 16) * ldc + col0; const float r = rs[ai][m];
#pragma unroll
                    for (int bj = 0; bj < 2; ++bj) { const f32x4 v0 = acc[ai][bj][m][0] * r, v1 = acc[ai][bj][m][1] * r;
                        u32x4 w; w.x = cvt_pk_bf16(v0[0], v0[1]); w.y = cvt_pk_bf16(v0[2], v0[3]); w.z = cvt_pk_bf16(v1[0], v1[1]); w.w = cvt_pk_bf16(v1[2], v1[3]);
                        *(u32x4*)(rowp + bj * HALF) = w; } }
        }
    }
};
struct EpiResN {
    static constexpr bool PERM = false, AFTER_DRAIN = false;
    const float* res; float* out; int ldc; bf16_t* An; const float* gain; float* slots; PG8_LAS float* xch; int write_a;
    __device__ __forceinline__ void operator()(const f32x4 (&acc)[2][2][4][2], const Unit& u, int wr, int wc, int fr, int fq) const {
        const int row0 = u.pm * BM + wr * 64 + fr, col0 = u.pn * BM + wc * 32 + 4 * fq;
        f32x4 gv[2][2];
#pragma unroll
        for (int bj = 0; bj < 2; ++bj)
#pragma unroll
            for (int n = 0; n < 2; ++n) gv[bj][n] = write_a ? *(const f32x4*)(gain + col0 + bj * HALF + n * 16) : (f32x4){0.f, 0.f, 0.f, 0.f};
#pragma unroll
        for (int ai = 0; ai < 2; ++ai)
#pragma unroll
            for (int m = 0; m < 4; ++m) { const size_t off = (size_t)(row0 + ai * HALF + m * 16) * ldc + col0; float ss = 0.f;
#pragma unroll
                for (int bj = 0; bj < 2; ++bj)
#pragma unroll
                    for (int n = 0; n < 2; ++n) { const f32x4 x = *(const f32x4*)(res + off + bj * HALF + n * 16) + acc[ai][bj][m][n]; *(f32x4*)(out + off + bj * HALF + n * 16) = x;
                        if (write_a) { const f32x4 a = x * gv[bj][n]; uint2 w; w.x = cvt_pk_bf16(a[0], a[1]); w.y = cvt_pk_bf16(a[2], a[3]); *(uint2*)(An + off + bj * HALF + n * 16) = w;
                            ss += (x[0] * x[0] + x[1] * x[1]) + (x[2] * x[2] + x[3] * x[3]); } }
                if (write_a) { ss += __shfl_xor(ss, 16); ss += __shfl_xor(ss, 32); if (fq == 0) xch[(ai * HALF + wr * 64 + m * 16 + fr) * 4 + wc] = ss; } }
        if (write_a) {
            asm volatile("s_waitcnt lgkmcnt(0)" ::: "memory"); __builtin_amdgcn_s_barrier(); asm volatile("" ::: "memory");
            if (wc == 0 && fq == 0) {
#pragma unroll
                for (int ai = 0; ai < 2; ++ai)
#pragma unroll
                    for (int m = 0; m < 4; ++m) { const int rl = ai * HALF + wr * 64 + m * 16 + fr; const f32x4 v = *(const PG8_LAS f32x4*)(xch + rl * 4);
                        slots[(size_t)(u.pm * BM + rl) * 4 + u.pn] = (v[0] + v[1]) + (v[2] + v[3]); } }
        }
    }
};

template <bool RES_BF16, bool OUT_F32> struct EpiResB {
    static constexpr bool PERM = true, AFTER_DRAIN = false;
    const void* res; void* out; int ldc; float* slots; PG8_LAS float* xch;
    __device__ __forceinline__ void operator()(const f32x4 (&acc)[2][2][4][2], const Unit& u, int wr, int wc, int fr, int fq) const {
        const int row0 = u.pm * BM + wr * 64 + fr, col0 = u.pn * BM + wc * 32 + 8 * fq;
#pragma unroll
        for (int ai = 0; ai < 2; ++ai)
#pragma unroll
            for (int m = 0; m < 4; ++m) { const size_t off = (size_t)(row0 + ai * HALF + m * 16) * ldc + col0; float ss = 0.f;
#pragma unroll
                for (int bj = 0; bj < 2; ++bj) { const size_t o2 = off + bj * HALF; f32x4 r0, r1;
                    if constexpr (RES_BF16) { const u32x4 w = *(const u32x4*)((const bf16_t*)res + o2);
                        r0 = (f32x4){__uint_as_float(w[0] << 16), __uint_as_float(w[0] & 0xffff0000u), __uint_as_float(w[1] << 16), __uint_as_float(w[1] & 0xffff0000u)};
                        r1 = (f32x4){__uint_as_float(w[2] << 16), __uint_as_float(w[2] & 0xffff0000u), __uint_as_float(w[3] << 16), __uint_as_float(w[3] & 0xffff0000u)}; }
                    else { r0 = *(const f32x4*)((const float*)res + o2); r1 = *(const f32x4*)((const float*)res + o2 + 4); }
                    const f32x4 x0 = r0 + acc[ai][bj][m][0], x1 = r1 + acc[ai][bj][m][1];
                    if constexpr (OUT_F32) { *(f32x4*)((float*)out + o2) = x0; *(f32x4*)((float*)out + o2 + 4) = x1; }
                    else { u32x4 w; w[0] = cvt_pk_bf16(x0[0], x0[1]); w[1] = cvt_pk_bf16(x0[2], x0[3]); w[2] = cvt_pk_bf16(x1[0], x1[1]); w[3] = cvt_pk_bf16(x1[2], x1[3]); *(u32x4*)((bf16_t*)out + o2) = w;
                        ss += ((x0[0] * x0[0] + x0[1] * x0[1]) + (x0[2] * x0[2] + x0[3] * x0[3])) + ((x1[0] * x1[0] + x1[1] * x1[1]) + (x1[2] * x1[2] + x1[3] * x1[3])); } }
                if constexpr (!OUT_F32) { ss += __shfl_xor(ss, 16); ss += __shfl_xor(ss, 32); if (fq == 0) xch[(ai * HALF + wr * 64 + m * 16 + fr) * 4 + wc] = ss; } }
        if constexpr (!OUT_F32) {
            asm volatile("s_waitcnt lgkmcnt(0)" ::: "memory"); __builtin_amdgcn_s_barrier(); asm volatile("" ::: "memory");
            if (wc == 0 && fq == 0) {
#pragma unroll
                for (int ai = 0; ai < 2; ++ai)
#pragma unroll
                    for (int m = 0; m < 4; ++m) { const int rl = ai * HALF + wr * 64 + m * 16 + fr; const f32x4 v = *(const PG8_LAS f32x4*)(xch + rl * 4);
                        slots[(size_t)(u.pm * BM + rl) * 4 + u.pn] = (v[0] + v[1]) + (v[2] + v[3]); } }
        }
    }
};

__device__ __forceinline__ float dpp_ror1(float v)  { return __builtin_bit_cast(float, __builtin_amdgcn_update_dpp(0, __builtin_bit_cast(int, v), 0x121, 0xf, 0xf, false)); }
__device__ __forceinline__ float dpp_ror15(float v) { return __builtin_bit_cast(float, __builtin_amdgcn_update_dpp(0, __builtin_bit_cast(int, v), 0x12f, 0xf, 0xf, false)); }
__device__ __forceinline__ float gelu_tanh(float x) { const float u = 0.7978845608028654f * (x + 0.044715f * x * x * x); return x / (1.0f + __expf(-2.0f * u)); }
struct EpiUp {
    static constexpr bool PERM = true, AFTER_DRAIN = false;
    bf16_t* ACT; const float* cw; const float* cb; int Tg, Mtok, dff; PG8_LAS float* xg; const float* slots;
    __device__ __forceinline__ void operator()(const f32x4 (&acc_)[2][2][4][2], const Unit& u, int wr, int wc, int fr, int fq) const {
        const int jj = wc * 32 + 8 * fq, j = u.pn * 128 + jj;
        f32x4 (&acc)[2][2][4][2] = const_cast<f32x4 (&)[2][2][4][2]>(acc_);
#pragma unroll
        for (int ai = 0; ai < 2; ++ai) {
            if (fr == 0) {
#pragma unroll
                for (int n = 0; n < 2; ++n) *(PG8_LAS f32x4*)(xg + ((ai * 2 + wr) * 2 + 0) * 128 + jj + 4 * n) = acc[ai][0][0][n]; }
            if (fr == 15) {
#pragma unroll
                for (int n = 0; n < 2; ++n) *(PG8_LAS f32x4*)(xg + ((ai * 2 + wr) * 2 + 1) * 128 + jj + 4 * n) = acc[ai][0][3][n]; }
        }
        { const int tix = (wr * 4 + wc) * 64 + fq * 16 + fr, wi = tix >> 7, ci = tix & 127;
          xg[1024 + tix] = wi < 3 ? cw[wi * dff + u.pn * 128 + ci] : cb[u.pn * 128 + ci];
          if (tix < 256) { int t = a_tok0(u.pm) + tix; t = t < 0 ? 0 : (t > Mtok - 1 ? Mtok - 1 : t); xg[1536 + tix] = row_rstd(slots, t, 1024, 1e-6f); } }
        asm volatile("s_waitcnt lgkmcnt(0)" ::: "memory"); __builtin_amdgcn_s_barrier(); asm volatile("" ::: "memory");
#pragma unroll
        for (int ai = 0; ai < 2; ++ai)
#pragma unroll
            for (int m = 0; m < 4; ++m) { const float r = xg[1536 + ai * HALF + wr * 64 + m * 16 + fr];
#pragma unroll
                for (int bj = 0; bj < 2; ++bj)
#pragma unroll
                    for (int n = 0; n < 2; ++n) acc[ai][bj][m][n] *= r; }
        typedef float v2f __attribute__((ext_vector_type(2)));
        const PG8_LAS float* wl = xg + 1024;
#pragma unroll
        for (int ai = 0; ai < 2; ++ai) {
            const int sp = wr == 1 ? ((ai * 2 + 0) * 2 + 1) : (ai == 1 ? ((0 * 2 + 1) * 2 + 1) : -1);
            const int sn = wr == 0 ? ((ai * 2 + 1) * 2 + 0) : (ai == 0 ? ((1 * 2 + 0) * 2 + 0) : -1);
#pragma unroll
            for (int m = 0; m < 4; ++m) {
                const int lr = ai * HALF + wr * 64 + m * 16 + fr, t = a_tok0(u.pm) + lr, tq = t & (Tg - 1);
                const float mp = tq == 0 ? 0.f : 1.f, mn = tq == Tg - 1 ? 0.f : 1.f;
                u32x4 ov;
#pragma unroll
                for (int n = 0; n < 2; ++n) {
                    const f32x4 w0 = *(const PG8_LAS f32x4*)(wl + jj + 4 * n), w1 = *(const PG8_LAS f32x4*)(wl + 128 + jj + 4 * n), w2 = *(const PG8_LAS f32x4*)(wl + 256 + jj + 4 * n), bb = *(const PG8_LAS f32x4*)(wl + 384 + jj + 4 * n);
                    f32x4 bp = {0.f, 0.f, 0.f, 0.f}, bn = {0.f, 0.f, 0.f, 0.f};
                    if (m == 0 && sp >= 0) bp = *(const PG8_LAS f32x4*)(xg + sp * 128 + jj + 4 * n) * xg[1536 + ai * HALF + wr * 64 - 1];
                    if (m == 3 && sn >= 0) bn = *(const PG8_LAS f32x4*)(xg + sn * 128 + jj + 4 * n) * xg[1536 + ai * HALF + wr * 64 + 64];
#pragma unroll
                    for (int eh = 0; eh < 2; ++eh) { v2f gv, p, q, up;
#pragma unroll
                        for (int k = 0; k < 2; ++k) { const int e = 2 * eh + k; const float g0 = acc[ai][0][m][n][e];
                            const float pa = m > 0 ? dpp_ror1(acc[ai][0][m > 0 ? m - 1 : 0][n][e]) : bp[e];
                            const float qa = m < 3 ? dpp_ror15(acc[ai][0][m < 3 ? m + 1 : 3][n][e]) : bn[e];
                            gv[k] = g0; up[k] = acc[ai][1][m][n][e];
                            p[k] = __builtin_bit_cast(float, __builtin_amdgcn_update_dpp(__builtin_bit_cast(int, pa), __builtin_bit_cast(int, g0), 0x111, 0xf, 0xf, false));
                            q[k] = __builtin_bit_cast(float, __builtin_amdgcn_update_dpp(__builtin_bit_cast(int, qa), __builtin_bit_cast(int, g0), 0x101, 0xf, 0xf, false)); }
                        const v2f a0 = (v2f){w0[2 * eh], w0[2 * eh + 1]} * mp, a1 = (v2f){w1[2 * eh], w1[2 * eh + 1]}, a2 = (v2f){w2[2 * eh], w2[2 * eh + 1]} * mn, ab = (v2f){bb[2 * eh], bb[2 * eh + 1]};
                        const v2f x = a0 * p + (a1 * gv + (a2 * q + ab));
                        const v2f arg = x * ((x * x) * (-0.10294324f) + (-2.3022082f));
                        v2f ex; ex[0] = __builtin_amdgcn_exp2f(arg[0]); ex[1] = __builtin_amdgcn_exp2f(arg[1]);
                        const v2f dn = ex + 1.0f; v2f rc; rc[0] = __builtin_amdgcn_rcpf(dn[0]); rc[1] = __builtin_amdgcn_rcpf(dn[1]);
                        const v2f y = (x * rc) * up;
                        ov[2 * n + eh] = cvt_pk_bf16(y[0], y[1]); }
                }
                if (lr >= 1 && lr <= 254 && t < Mtok) *(u32x4*)(ACT + (size_t)t * dff + j) = ov;
            }
        }
    }
    __device__ __forceinline__ int a_tok0(int pm) const { return 254 * pm - 1; }
};

template <class Epi, class Sched, bool ALIGN_EPI = false, bool SP2 = false>
__device__ __forceinline__ void gemm_phase(PG8_LAS unsigned char* lds, const Gemm g, const Sched& S, const Epi& E, const int tid) {
    const int wid = __builtin_amdgcn_readfirstlane(tid >> 6), lane = tid & 63, wr = wid >> 2, wc = wid & 3, fr = lane & 15, fq = lane >> 4;
    const int K = g.K, nt = K / BK;
    unsigned voffA[2], voffB[2];
#pragma unroll
    for (int i = 0; i < 2; ++i) { int R, C; stage_rc(tid * 16 + i * 8192, R, C); const int Rb = Epi::PERM ? ((R & ~31) + perm32(R & 31)) : R;
        voffA[i] = (unsigned)(R * K + C) * 2u; voffB[i] = (unsigned)(Rb * K + C) * 2u; }
    const size_t kstep = (size_t)(BK * 2);
    const size_t hstep = (size_t)HALF * K * 2;
    const size_t tstep = 2 * hstep;
    const size_t tstepA = (size_t)g.a_rows * K * 2;
    const unsigned ldsw = (unsigned)wid * 1024u;
    const int aoff = lds_byte(wr * 64 + fr, fq * 8), boff = lds_byte(wc * 32 + fr, fq * 8);
#define PG8_SA(b, h) (((b) * 2 + (h)) * HTB)
#define PG8_SB(b, h) ((4 + (b) * 2 + (h)) * HTB)
#define PG8_STAGE(bufoff, gbase, voff) do { _Pragma("unroll") for (int _i = 0; _i < 2; ++_i) \
        __builtin_amdgcn_global_load_lds((const unsigned*)((const char*)(gbase) + (voff)[_i]), (PG8_LAS unsigned*)(lds + (bufoff) + ldsw + _i * 8192), 16, 0, 0); } while (0)
#define PG8_LDA(dst, b, h) do { _Pragma("unroll") for (int m = 0; m < 4; ++m) _Pragma("unroll") for (int k = 0; k < 2; ++k) dst[m][k] = *(const PG8_LAS bf16x8*)(lds + PG8_SA(b, h) + aoff + m * 2048 + k * 1024); } while (0)
#define PG8_LDB(dst, b, h) do { _Pragma("unroll") for (int n = 0; n < 2; ++n) _Pragma("unroll") for (int k = 0; k < 2; ++k) dst[n][k] = *(const PG8_LAS bf16x8*)(lds + PG8_SB(b, h) + boff + n * 2048 + k * 1024); } while (0)
#define PG8_MMA(ai, bj, At, Bt) do { __builtin_amdgcn_s_setprio(1); _Pragma("unroll") for (int m = 0; m < 4; ++m) _Pragma("unroll") for (int n = 0; n < 2; ++n) _Pragma("unroll") for (int k = 0; k < 2; ++k) \
        acc[ai][bj][m][n] = __builtin_amdgcn_mfma_f32_16x16x32_bf16(Bt[n][k], At[m][k], acc[ai][bj][m][n], 0, 0, 0); __builtin_amdgcn_s_setprio(0); } while (0)
#define PG8_WAIT_V(n) asm volatile("s_waitcnt vmcnt(" #n ")" ::: "memory")
#define PG8_WAIT_L(n) asm volatile("s_waitcnt lgkmcnt(" #n ")" ::: "memory")
#define PG8_BAR __builtin_amdgcn_s_barrier()
#define PG8_SCHED __builtin_amdgcn_sched_barrier(0)
    Unit cur, nxt; int ui = 0;
    if (!S.next(0, cur)) return;
    f32x4 acc[2][2][4][2];
#pragma unroll
    for (int a = 0; a < 2; ++a)
#pragma unroll
        for (int b = 0; b < 2; ++b)
#pragma unroll
            for (int m = 0; m < 4; ++m)
#pragma unroll
                for (int n = 0; n < 2; ++n) acc[a][b][m][n] = (f32x4){0.f, 0.f, 0.f, 0.f};
    bf16x8 At[4][2], B0[2][2], B1[2][2];
    const char* cA = (const char*)g.A + (size_t)cur.pm * tstepA; const char* cB = (const char*)g.Bt + (size_t)cur.pn * tstep;
    S.a_ready(cur);
    if constexpr (SP2) {
        PG8_STAGE(PG8_SB(0, 0), cB, voffB); PG8_STAGE(PG8_SB(0, 1), cB + hstep, voffB); PG8_STAGE(PG8_SA(0, 0), cA, voffA); PG8_STAGE(PG8_SA(0, 1), cA + hstep, voffA);
        if (wr == 1) PG8_BAR;
        PG8_WAIT_V(2); PG8_BAR;
        PG8_STAGE(PG8_SB(1, 0), cB + kstep, voffB); PG8_STAGE(PG8_SA(1, 0), cA + kstep, voffA); PG8_STAGE(PG8_SB(1, 1), cB + hstep + kstep, voffB);
        PG8_WAIT_V(6); PG8_BAR;
    } else {
        PG8_STAGE(PG8_SB(0, 0), cB, voffB); PG8_STAGE(PG8_SA(0, 0), cA, voffA); PG8_STAGE(PG8_SB(0, 1), cB + hstep, voffB); PG8_STAGE(PG8_SA(0, 1), cA + hstep, voffA);
        if (wr == 1) PG8_BAR;
        PG8_WAIT_V(4); PG8_BAR;
        PG8_STAGE(PG8_SB(1, 0), cB + kstep, voffB); PG8_STAGE(PG8_SA(1, 0), cA + kstep, voffA); PG8_STAGE(PG8_SB(1, 1), cB + hstep + kstep, voffB);
        PG8_WAIT_V(6); PG8_BAR;
    }
    for (;;) {
        const bool has_next = S.next(ui + 1, nxt);
        const char* nA = has_next ? (const char*)g.A + (size_t)nxt.pm * tstepA : cA; const char* nB = has_next ? (const char*)g.Bt + (size_t)nxt.pn * tstep : cB;
        for (int t = 0; t < nt; t += 2) {
            const bool last = (t == nt - 2);
            const char* a1 = cA + (size_t)(t + 1) * kstep;
            const char* a2 = last ? nA : cA + (size_t)(t + 2) * kstep; const char* b2 = last ? nB : cB + (size_t)(t + 2) * kstep;
            const char* a3 = a2 + kstep; const char* b3 = b2 + kstep;
            if (last && has_next) S.a_ready(nxt);
            if constexpr (SP2) {
            PG8_LDB(B0, 0, 0); PG8_LDB(B1, 0, 1); PG8_SCHED; PG8_LDA(At, 0, 0); PG8_STAGE(PG8_SA(1, 1), a1 + hstep, voffA);
            PG8_WAIT_V(8); PG8_WAIT_L(0); PG8_BAR; PG8_MMA(0, 0, At, B0); PG8_MMA(0, 1, At, B1); PG8_BAR; PG8_SCHED;
            PG8_LDA(At, 0, 1); PG8_STAGE(PG8_SB(0, 0), b2, voffB); PG8_STAGE(PG8_SB(0, 1), b2 + hstep, voffB); PG8_STAGE(PG8_SA(0, 0), a2, voffA);
            PG8_WAIT_V(8); PG8_WAIT_L(0); PG8_BAR; PG8_MMA(1, 0, At, B0); PG8_MMA(1, 1, At, B1); PG8_BAR; PG8_SCHED;
            PG8_LDB(B0, 1, 0); PG8_LDB(B1, 1, 1); PG8_SCHED; PG8_LDA(At, 1, 0); PG8_STAGE(PG8_SA(0, 1), a2 + hstep, voffA);
            PG8_WAIT_V(8); PG8_WAIT_L(0); PG8_BAR; PG8_MMA(0, 0, At, B0); PG8_MMA(0, 1, At, B1); PG8_BAR; PG8_SCHED;
            PG8_LDA(At, 1, 1); PG8_STAGE(PG8_SB(1, 0), b3, voffB); PG8_STAGE(PG8_SB(1, 1), b3 + hstep, voffB); PG8_STAGE(PG8_SA(1, 0), a3, voffA);
            PG8_WAIT_V(8); PG8_WAIT_L(0); PG8_BAR; PG8_MMA(1, 0, At, B0); PG8_MMA(1, 1, At, B1); PG8_BAR; PG8_SCHED;
            } else {
            PG8_LDB(B0, 0, 0); PG8_SCHED; PG8_LDA(At, 0, 0); PG8_STAGE(PG8_SA(1, 1), a1 + hstep, voffA);
            PG8_WAIT_L(8); PG8_BAR; PG8_WAIT_L(0); PG8_MMA(0, 0, At, B0); PG8_BAR; PG8_SCHED;
            PG8_LDB(B1, 0, 1); PG8_STAGE(PG8_SB(0, 0), b2, voffB);
            PG8_BAR; PG8_WAIT_L(0); PG8_MMA(0, 1, At, B1); PG8_BAR;
            PG8_LDA(At, 0, 1); PG8_STAGE(PG8_SA(0, 0), a2, voffA);
            PG8_BAR; PG8_WAIT_L(0); PG8_MMA(1, 0, At, B0); PG8_BAR; PG8_SCHED;
            PG8_STAGE(PG8_SB(0, 1), b2 + hstep, voffB);
            PG8_WAIT_V(6); PG8_BAR; PG8_MMA(1, 1, At, B1); PG8_BAR;
            PG8_LDB(B0, 1, 0); PG8_SCHED; PG8_LDA(At, 1, 0); PG8_STAGE(PG8_SA(0, 1), a2 + hstep, voffA);
            PG8_WAIT_L(8); PG8_BAR; PG8_WAIT_L(0); PG8_MMA(0, 0, At, B0); PG8_BAR; PG8_SCHED;
            PG8_LDB(B1, 1, 1); PG8_STAGE(PG8_SB(1, 0), b3, voffB);
            PG8_BAR; PG8_WAIT_L(0); PG8_MMA(0, 1, At, B1); PG8_BAR;
            PG8_LDA(At, 1, 1); PG8_STAGE(PG8_SA(1, 0), a3, voffA);
            PG8_BAR; PG8_WAIT_L(0); PG8_MMA(1, 0, At, B0); PG8_BAR; PG8_SCHED;
            PG8_STAGE(PG8_SB(1, 1), b3 + hstep, voffB);
            PG8_WAIT_V(6); PG8_BAR; PG8_MMA(1, 1, At, B1); PG8_BAR;
            }
        }
        if constexpr (ALIGN_EPI) { if (wr == 0) PG8_BAR; }
        if constexpr (!Epi::AFTER_DRAIN) { E(acc, cur, wr, wc, fr, fq); S.done(cur); }
        if (!has_next) break;
#pragma unroll
        for (int a = 0; a < 2; ++a)
#pragma unroll
            for (int b = 0; b < 2; ++b)
#pragma unroll
                for (int m = 0; m < 4; ++m)
#pragma unroll
                    for (int n = 0; n < 2; ++n) acc[a][b][m][n] = (f32x4){0.f, 0.f, 0.f, 0.f};
        cur = nxt; cA = nA; cB = nB; ++ui;
        if constexpr (ALIGN_EPI) { if (wr == 1) PG8_BAR; }
    }
    PG8_WAIT_V(0);
    if constexpr (!ALIGN_EPI) { if (wr == 0) PG8_BAR; }
    PG8_BAR;
    if constexpr (Epi::AFTER_DRAIN) { E.fused(acc, cur, wr, wc, fr, fq, lds, wid, lane); S.done(cur); }
#undef PG8_SA
#undef PG8_SB
#undef PG8_STAGE
#undef PG8_LDA
#undef PG8_LDB
#undef PG8_MMA
#undef PG8_WAIT_V
#undef PG8_WAIT_L
#undef PG8_BAR
#undef PG8_SCHED
}
}
#define LAS __attribute__((address_space(3)))
#define DI __device__ __forceinline__
typedef unsigned short bf16;
typedef short bf16x8 __attribute__((ext_vector_type(8)));
typedef short s16x4 __attribute__((ext_vector_type(4)));
typedef float f32x4 __attribute__((ext_vector_type(4)));
typedef unsigned u32x4 __attribute__((ext_vector_type(4)));
constexpr int NT = 512;
constexpr int LDS_BYTES = 160 * 1024;
constexpr int MG = 16384;
constexpr int DM = 1024, NIN = 4096, DFF = 2816, NUP = 5632;
constexpr int C_AQ = 0, C_AK = 256, C_AV = 512, C_BQ = 768, C_BK = 1024, C_BV = 1280, C_CQ = 1536, C_CFF = 2048, C_CFB = 2560, C_CI = 3072, C_CG = 3584;
constexpr size_t MiB = 1u << 20;
constexpr size_t WS_LB = 0, WS_WIN = 1 * MiB, WS_WOUT = 17 * MiB, WS_WUP = 21 * MiB, WS_WDOWN = 43 * MiB, WS_H = 55 * MiB, WS_PROJ = 88 * MiB, WS_ST = 216 * MiB,
                 WS_GU = 88 * MiB, WS_ADEC = 280 * MiB, WS_DAO = 281 * MiB, WS_DALSE = 305 * MiB, WS_ACT = 306 * MiB, WS_KT1 = 394 * MiB, WS_QHB = 426 * MiB, WS_ATOT = 458 * MiB, WS_QTB = 459 * MiB, WS_END = 491 * MiB;
constexpr size_t SZ_WIN = (size_t)NIN * DM * 2, SZ_WOUT = (size_t)DM * DM * 2, SZ_WUP = (size_t)NUP * DM * 2, SZ_WDOWN = (size_t)DM * DFF * 2;
constexpr float EPS = 1e-6f;
__device__ const unsigned char T5_BUCKET[3][129] = {
{11,11,11,11,11,11,11,11,11,11,11,11,11,11,11,10,10,10,10,10,10,10,10,10,10,10,10,10,10,10,10,10,10,10,10,10,10,10,9,9,9,9,9,9,9,9,9,9,9,9,8,8,8,8,8,8,8,7,6,5,4,3,2,1,0,17,18,19,20,21,22,23,24,24,24,24,24,24,24,25,25,25,25,25,25,25,25,25,25,25,25,26,26,26,26,26,26,26,26,26,26,26,26,26,26,26,26,26,26,26,26,26,26,26,27,27,27,27,27,27,27,27,27,27,27,27,27,27,27},
{13,13,13,13,13,13,13,13,13,13,13,13,13,13,13,13,13,13,13,13,13,13,13,12,12,12,12,12,12,12,12,12,12,12,12,12,12,12,12,12,12,12,11,11,11,11,11,11,11,11,11,11,10,10,10,10,10,10,9,9,9,8,8,4,0,20,24,24,25,25,25,26,26,26,26,26,26,27,27,27,27,27,27,27,27,27,27,28,28,28,28,28,28,28,28,28,28,28,28,28,28,28,28,28,28,28,29,29,29,29,29,29,29,29,29,29,29,29,29,29,29,29,29,29,29,29,29,29,29},
{15,15,15,15,15,15,15,15,15,15,15,15,15,15,15,15,15,15,15,15,15,15,15,15,15,15,15,15,15,15,14,14,14,14,14,14,14,14,14,14,14,14,14,14,14,13,13,13,13,13,13,13,13,13,12,12,12,12,12,11,11,10,10,9,0,25,26,26,27,27,28,28,28,28,28,29,29,29,29,29,29,29,29,29,30,30,30,30,30,30,30,30,30,30,30,30,30,30,30,31,31,31,31,31,31,31,31,31,31,31,31,31,31,31,31,31,31,31,31,31,31,31,31,31,31,31,31,31,31}};

struct Ctx {
    const float *xp, *xs, *ln_mix_g, *w_in, *na_q_g, *na_k_g, *na_rpb, *da_q_g, *da_k_g, *t5_bias, *hg_lb_logits, *hg_norm_g, *w_out, *ln_ffn_g, *w_up, *conv_w, *conv_b, *w_down;
    float* out; unsigned char* ws;
};

DI float bf2f(unsigned v) { return __uint_as_float(v << 16); }
DI float bflo(unsigned w) { return __uint_as_float(w << 16); }
DI float bfhi(unsigned w) { return __uint_as_float(w & 0xffff0000u); }
DI unsigned pk(float lo, float hi) { return pg8::cvt_pk_bf16(lo, hi); }
DI int clampi(int v, int lo, int hi) { return v < lo ? lo : (v > hi ? hi : v); }
DI f32x4 mfma32(bf16x8 a, bf16x8 b, f32x4 c) { return __builtin_amdgcn_mfma_f32_16x16x32_bf16(a, b, c, 0, 0, 0); }
DI f32x4 mfma16(s16x4 a, s16x4 b, f32x4 c) { return __builtin_amdgcn_mfma_f32_16x16x16bf16_1k(a, b, c, 0, 0, 0); }
DI s16x4 pack4(f32x4 v) { uint2 w; w.x = pk(v[0], v[1]); w.y = pk(v[2], v[3]); return __builtin_bit_cast(s16x4, w); }
DI bf16x8 ld_contig(const LAS bf16* img, int ld, int r0, int c0, int lane) { return *(const LAS bf16x8*)(img + (r0 + (lane & 15)) * ld + c0 + (lane >> 4) * 8); }
DI bf16x8 ld_tr8(const LAS bf16* img, int ld, int k0, int n0, int lane) {
    const int g = lane >> 4, li = lane & 15, q = li >> 2, p = li & 3;
    const LAS bf16* a = img + (k0 + g * 8 + q) * ld + n0 + 4 * p;
    const s16x4 lo = __builtin_amdgcn_ds_read_tr16_b64_v4i16((LAS s16x4*)a);
    const s16x4 hi = __builtin_amdgcn_ds_read_tr16_b64_v4i16((LAS s16x4*)(a + 4 * ld));
    return (bf16x8){lo[0], lo[1], lo[2], lo[3], hi[0], hi[1], hi[2], hi[3]};
}
DI s16x4 ld_tr4(const LAS bf16* img, int ld, int k0, int n0, int lane) {
    const int g = lane >> 4, li = lane & 15, q = li >> 2, p = li & 3;
    return __builtin_amdgcn_ds_read_tr16_b64_v4i16((LAS s16x4*)(img + (k0 + g * 4 + q) * ld + n0 + 4 * p));
}
DI void gate_fn(float z, float lb, float& lf, float& kk) {
    const float ez = __expf(-z), s = __builtin_amdgcn_rcpf(1.0f + ez);
    lf = __builtin_amdgcn_logf(lb + (1.0f - lb) * s) * 0.69314718056f;
    kk = (1.0f - lb) * (ez * s);
}
DI int fr_off(int r, int k) { return (((((r >> 4) * 4 + (k >> 5)) * 64) + ((k >> 3) & 3) * 16 + (r & 15)) << 3) + (k & 7); }
DI float silu_f(float x) { return x * __builtin_amdgcn_rcpf(1.0f + __expf(-x)); }

DI void transpose_w(const float* W, bf16* Bt, int K, int N, int mode, const float* rowgain, LAS float* tile, int bid, int nb, int tid) {
    const int tk = K / 64, tn = N / 64;
    for (int t = bid; t < tk * tn; t += nb) {
        const int k0 = (t % tk) * 64, n0 = (t / tk) * 64;
        int ns0 = n0; if (mode) { const int pn = n0 >> 8, jj = n0 & 255; ns0 = (jj < 128) ? pn * 128 + jj : DFF + pn * 128 + (jj - 128); }
#pragma unroll
        for (int it = 0; it < 8; ++it) { const int r = (tid >> 6) + 8 * it, cc = tid & 63; tile[r * 65 + cc] = W[(size_t)(k0 + r) * N + ns0 + cc] * (rowgain ? rowgain[k0 + r] : 1.0f); }
        __syncthreads();
#pragma unroll
        for (int it = 0; it < 4; ++it) { const int nn = (tid >> 5) + 16 * it, kp = tid & 31;
            *(unsigned*)(Bt + (size_t)(n0 + nn) * K + k0 + 2 * kp) = pk(tile[(2 * kp) * 65 + nn], tile[(2 * kp + 1) * 65 + nn]); }
        __syncthreads();
    }
}
DI void phase_prologue(const Ctx& c, LAS unsigned char* lds, int bid, int nb, int tid) {
    LAS float* tile = (LAS float*)lds;
    for (int l = 0; l < 2; ++l) {
        transpose_w(c.w_in + (size_t)l * DM * NIN, (bf16*)(c.ws + WS_WIN + l * SZ_WIN), DM, NIN, 0, c.ln_mix_g + l * DM, tile, bid, nb, tid);
        transpose_w(c.w_out + (size_t)l * DM * DM, (bf16*)(c.ws + WS_WOUT + l * SZ_WOUT), DM, DM, 0, nullptr, tile, bid, nb, tid);
        transpose_w(c.w_up + (size_t)l * DM * NUP, (bf16*)(c.ws + WS_WUP + l * SZ_WUP), DM, NUP, 1, c.ln_ffn_g + l * DM, tile, bid, nb, tid);
        transpose_w(c.w_down + (size_t)l * DFF * DM, (bf16*)(c.ws + WS_WDOWN + l * SZ_WDOWN), DFF, DM, 0, nullptr, tile, bid, nb, tid);
    }
    if (bid == 0) { float* LB = (float*)(c.ws + WS_LB);
        for (int i = tid; i < 1024; i += NT) { const int dir = i >> 9, ci = i & 511; const float l0 = c.hg_lb_logits[(dir * 2 + 0) * 512 + ci], l1 = c.hg_lb_logits[(dir * 2 + 1) * 512 + ci];
            LB[(dir * 2 + 0) * 512 + ci] = 0.0f; LB[(dir * 2 + 1) * 512 + ci] = 1.0f / (1.0f + expf(l0 - l1)); } }
}

DI void phase_norm(const float* x, const float* gain, bf16* H, int bid, int nb, int tid) {
    const int wave = tid >> 6, lane = tid & 63;
    for (int row = bid * 8 + wave; row < MG; row += nb * 8) {
        const float4* xr = (const float4*)(x + (size_t)row * DM); float4 v[4]; float ss = 0.f;
#pragma unroll
        for (int q = 0; q < 4; ++q) { v[q] = xr[lane + 64 * q]; ss += v[q].x * v[q].x + v[q].y * v[q].y + v[q].z * v[q].z + v[q].w * v[q].w; }
#pragma unroll
        for (int o = 32; o >= 1; o >>= 1) ss += __shfl_xor(ss, o);
        const float r = rsqrtf(ss * (1.0f / DM) + EPS);
#pragma unroll
        for (int q = 0; q < 4; ++q) { const float4 gg = ((const float4*)gain)[lane + 64 * q]; uint2 w; w.x = pk(v[q].x * r * gg.x, v[q].y * r * gg.y); w.y = pk(v[q].z * r * gg.z, v[q].w * r * gg.w);
            *(uint2*)(H + (size_t)row * DM + (lane + 64 * q) * 4) = w; }
    }
}

DI void phase_xcast(const float* x, bf16* H, float* slots, int bid, int nb, int tid) {
    const int wave = tid >> 6, lane = tid & 63;
    for (int row = bid * 8 + wave; row < MG; row += nb * 8) {
        const float4* xr = (const float4*)(x + (size_t)row * DM); float4 v[4]; float ss = 0.f;
#pragma unroll
        for (int q = 0; q < 4; ++q) { v[q] = xr[lane + 64 * q]; ss += v[q].x * v[q].x + v[q].y * v[q].y + v[q].z * v[q].z + v[q].w * v[q].w; }
#pragma unroll
        for (int o = 32; o >= 1; o >>= 1) ss += __shfl_xor(ss, o);
#pragma unroll
        for (int q = 0; q < 4; ++q) { uint2 w; w.x = pk(v[q].x, v[q].y); w.y = pk(v[q].z, v[q].w); *(uint2*)(H + (size_t)row * DM + (lane + 64 * q) * 4) = w; }
        if (lane == 0) *(float4*)(slots + (size_t)row * 4) = make_float4(ss, 0.f, 0.f, 0.f);
    }
}

DI void phase_qknorm(const Ctx& c, int l, bf16* PROJ, int bid, int nb, int tid) {
    for (int idx = bid * NT + tid; idx < MG * 128; idx += nb * NT) {
        const int sub = idx & 7, vec = (idx >> 3) & 15, tok = idx >> 7, which = vec >> 2, hh = vec & 3;
        const int col = (which == 0 ? C_AQ : which == 1 ? C_AK : which == 2 ? C_BQ : C_BK) + hh * 64 + sub * 8;
        const float* gp = (which == 0 ? c.na_q_g : which == 1 ? c.na_k_g : which == 2 ? c.da_q_g : c.da_k_g) + l * 64 + sub * 8;
        uint4* p = (uint4*)(PROJ + (size_t)tok * NIN + col); const uint4 w = *p;
        float v[8] = {bflo(w.x), bfhi(w.x), bflo(w.y), bfhi(w.y), bflo(w.z), bfhi(w.z), bflo(w.w), bfhi(w.w)};
        float ss = 0.f;
#pragma unroll
        for (int i = 0; i < 8; ++i) ss += v[i] * v[i];
        ss += __shfl_xor(ss, 1); ss += __shfl_xor(ss, 2); ss += __shfl_xor(ss, 4);
        const float r = rsqrtf(ss * (1.0f / 64.0f) + EPS) * ((which & 1) ? 1.0f : 0.125f);
        const float4 g0 = *(const float4*)gp, g1 = *(const float4*)(gp + 4);
        uint4 o; o.x = pk(v[0] * r * g0.x, v[1] * r * g0.y); o.y = pk(v[2] * r * g0.z, v[3] * r * g0.w); o.z = pk(v[4] * r * g1.x, v[5] * r * g1.y); o.w = pk(v[6] * r * g1.z, v[7] * r * g1.w);
        *p = o;
    }
}

DI void phase_na(const Ctx& c, LAS unsigned char* lds, int g, int l, const bf16* PROJ, bf16* MIX, int bid, int nb, int tid) {
    const int Tg = g < 2 ? 16384 : 4096, nseq = g < 2 ? 1 : 4, rows = Tg / 64, nunits = nseq * (rows / 2) * 4;
    LAS bf16* Vimg = (LAS bf16*)lds;
    LAS unsigned char* Kimg = lds + 576 * 72 * 2;
    LAS float* rpbs = (LAS float*)(lds + 576 * 72 * 2 + 576 * 128);
    const int w = tid >> 6, lane = tid & 63, gq = lane >> 4, li = lane & 15;
    int dcx[8];
    { const int n_ = w & 3, kb0_ = clampi(16 * n_ - 8, 0, 32), cq_ = 16 * n_ + li, c0_ = clampi(cq_ - 8, 0, 48);
#pragma unroll
      for (int i = 0; i < 8; ++i) { const int kcol = kb0_ + 16 * (i >> 2) + gq * 4 + (i & 3); const bool ok = (kcol >= c0_) && (kcol < c0_ + 16); dcx[i] = ok ? clampi(kcol - cq_, -15, 15) + 15 : 31; } }
    const bool xa = (nb & 7) == 0;
    const int xcd = xa ? (bid & 7) : 0, slot = xa ? (bid >> 3) : bid, wpx = xa ? (nb >> 3) : nb, upx = xa ? (nunits >> 3) : nunits;
    u32x4 pv[9], pkk[9];
#define NA_PREFETCH(UNIT) do { const int h_ = (UNIT) >> 7, rp_ = ((UNIT) & 127) % (rows / 2), s_ = ((UNIT) & 127) / (rows / 2), rb_ = clampi(2 * rp_ - 4, 0, rows - 8), tb_ = s_ * Tg; \
        _Pragma("unroll") for (int i_ = 0; i_ < 9; ++i_) { const int ch_ = tid + i_ * NT, key_ = ch_ >> 3, sub_ = ch_ & 7; int gr_ = rb_ + (key_ >> 6); gr_ = gr_ > rows - 1 ? rows - 1 : gr_; \
            const bf16* p_ = PROJ + (size_t)(tb_ + gr_ * 64 + (key_ & 63)) * NIN + h_ * 64 + sub_ * 8; pv[i_] = *(const u32x4*)(p_ + C_AV); pkk[i_] = *(const u32x4*)(p_ + C_AK); } } while (0)
    if (slot < upx) NA_PREFETCH(xcd * upx + slot);
    for (int iu = slot; iu < upx; iu += wpx) {
        const int unit = xcd * upx + iu;
        const int h = unit >> 7, rp = (unit & 127) % (rows / 2), s = (unit & 127) / (rows / 2);
        const int ra = 2 * rp, rbase = clampi(ra - 4, 0, rows - 8), tokbase = s * Tg;
        const int r = ra + (w >> 2), n = w & 3, r0 = clampi(r - 4, 0, rows - 8), kb0 = clampi(16 * n - 8, 0, 32);
        const int cq = 16 * n + li, c0 = clampi(cq - 8, 0, 48), qtok = tokbase + r * 64 + cq;
        const bf16* qp = PROJ + (size_t)qtok * NIN + C_AQ + h * 64 + gq * 8;
        const bf16x8 qf0 = *(const bf16x8*)qp, qf1 = *(const bf16x8*)(qp + 32);
        f32x4 sc[16];
#pragma unroll
        for (int i = 0; i < 9; ++i) { const int ch = tid + i * NT, key = ch >> 3, sub = ch & 7;
            *(LAS u32x4*)(Vimg + key * 72 + sub * 8) = pv[i]; *(LAS u32x4*)(Kimg + key * 128 + ((sub ^ (key & 7)) << 4)) = pkk[i]; }
        if (tid < 480) { const int rr_ = tid >> 5, cc_ = tid & 31; rpbs[tid] = cc_ < 31 ? c.na_rpb[(l * 4 + h) * 465 + rr_ * 31 + cc_] : -1e30f; }
        __syncthreads();
        if (iu + wpx < upx) NA_PREFETCH(xcd * upx + iu + wpx);
#pragma unroll
        for (int t = 0; t < 16; ++t) { const int rr = t >> 1, hf = t & 1, kr = r0 + rr;
            const int krw_ = (kr - rbase) * 64 + kb0 + 16 * hf + li; const LAS unsigned char* kb_ = Kimg + krw_ * 128;
            const bf16x8 ka_ = *(const LAS bf16x8*)(kb_ + ((gq ^ (krw_ & 7)) << 4)), kb2_ = *(const LAS bf16x8*)(kb_ + (((4 + gq) ^ (krw_ & 7)) << 4));
            f32x4 sv = {0.f, 0.f, 0.f, 0.f}; sv = mfma32(ka_, qf0, sv); sv = mfma32(kb2_, qf1, sv);
            const int dr = kr - r + 7;
#pragma unroll
            for (int j = 0; j < 4; ++j) sc[t][j] = sv[j] + rpbs[dr * 32 + dcx[hf * 4 + j]]; }
        float m = -3e38f;
#pragma unroll
        for (int t = 0; t < 16; ++t)
#pragma unroll
            for (int j = 0; j < 4; ++j) m = fmaxf(m, sc[t][j]);
        m = fmaxf(m, __shfl_xor(m, 16)); m = fmaxf(m, __shfl_xor(m, 32));
        float sum = 0.f;
#pragma unroll
        for (int t = 0; t < 16; ++t)
#pragma unroll
            for (int j = 0; j < 4; ++j) { const float p = __expf(sc[t][j] - m); sc[t][j] = p; sum += p; }
        sum += __shfl_xor(sum, 16); sum += __shfl_xor(sum, 32);
        f32x4 o[4];
#pragma unroll
        for (int dt = 0; dt < 4; ++dt) o[dt] = (f32x4){0.f, 0.f, 0.f, 0.f};
#pragma unroll
        for (int t = 0; t < 16; ++t) { const int rr = t >> 1, hf = t & 1, krow = (r0 + rr - rbase) * 64 + kb0 + 16 * hf; const s16x4 pb = pack4(sc[t]);
#pragma unroll
            for (int dt = 0; dt < 4; ++dt) o[dt] = mfma16(ld_tr4(Vimg, 72, krow, dt * 16, lane), pb, o[dt]); }
        const float inv = 1.0f / sum;
#pragma unroll
        for (int dt = 0; dt < 4; ++dt) { uint2 wv; wv.x = pk(o[dt][0] * inv, o[dt][1] * inv); wv.y = pk(o[dt][2] * inv, o[dt][3] * inv);
            *(uint2*)(MIX + (size_t)qtok * DM + h * 64 + dt * 16 + gq * 4) = wv; }
        __syncthreads();
    }
}
#undef NA_PREFETCH

DI void phase_da(const Ctx& c, LAS unsigned char* lds, int g, const bf16* PROJ, bf16* DAO, float* DALSE, int bid, int nb, int tid) {
    const int Tg = g < 2 ? 16384 : 4096;
    constexpr int VB = 256 * 72 * 2, BUFB = 2 * VB + 704;
    const int w = tid >> 6, lane = tid & 63, gq = lane >> 4, li = lane & 15;
    bf16x8 qf0, qf1; u32x4 vreg[4], kreg[4]; float treg = 0.f;
    int cfg, h, d, L, seq0, rho, u0;
#define DA_DECODE(UNIT) do { cfg = (UNIT) / 512; const int rem_ = (UNIT) % 512; h = rem_ >> 7; const int blk_ = rem_ & 127; d = 1 << (2 * cfg); L = Tg / d; const int nb128_ = L / 128, per_seq_ = d * nb128_; \
        const int s_ = blk_ / per_seq_, r2_ = blk_ % per_seq_; rho = r2_ / nb128_; u0 = (r2_ % nb128_) * 128; seq0 = s_ * Tg; } while (0)
#define DA_LOAD() do { \
        const bf16* qp_ = PROJ + (size_t)(seq0 + (u0 + 16 * w + li) * d + rho) * NIN + C_BQ + h * 64 + gq * 8; qf0 = *(const bf16x8*)qp_; qf1 = *(const bf16x8*)(qp_ + 32); \
        _Pragma("unroll") for (int i_ = 0; i_ < 4; ++i_) { const int ch_ = tid + i_ * NT, kl_ = ch_ >> 3, sub_ = ch_ & 7, uk_ = u0 - 64 + kl_; vreg[i_] = (u32x4){0u, 0u, 0u, 0u}; kreg[i_] = (u32x4){0u, 0u, 0u, 0u}; \
            if (uk_ >= 0 && uk_ < L) { const bf16* rp_ = PROJ + (size_t)(seq0 + uk_ * d + rho) * NIN + h * 64 + sub_ * 8; vreg[i_] = *(const u32x4*)(rp_ + C_BV); kreg[i_] = *(const u32x4*)(rp_ + C_BK); } } \
        if (tid < 176) { const int r64_ = tid - 16; treg = (r64_ >= 0 && r64_ <= 128) ? c.t5_bias[(int)T5_BUCKET[cfg][r64_ < 0 ? 0 : (r64_ > 128 ? 128 : r64_)] * 4 + h] : -1e30f; } } while (0)
#define DA_STAGE(B) do { LAS bf16* vi_ = (LAS bf16*)(lds + (B) * BUFB); \
        _Pragma("unroll") for (int i_ = 0; i_ < 4; ++i_) { const int ch_ = tid + i_ * NT, kl_ = ch_ >> 3, sub_ = ch_ & 7; *(LAS u32x4*)(vi_ + kl_ * 72 + sub_ * 8) = vreg[i_]; *(LAS u32x4*)(vi_ + 256 * 72 + kl_ * 72 + sub_ * 8) = kreg[i_]; } \
        if (tid < 176) ((LAS float*)(lds + (B) * BUFB + 2 * VB))[tid] = treg; } while (0)
    const bool xa = (nb & 7) == 0;
    const int xcd = xa ? (bid & 7) : 0, slot = xa ? (bid >> 3) : bid, wpx = xa ? (nb >> 3) : nb, UPX = xa ? 192 : 1536;
    int iu = slot, it = 0;
    if (iu < UPX) { DA_DECODE(xcd * UPX + iu); DA_LOAD(); DA_STAGE(0); }
    __syncthreads();
    for (; iu < UPX; iu += wpx, ++it) {
        const int b = it & 1;
        const LAS bf16* Vimg = (const LAS bf16*)(lds + b * BUFB); const LAS bf16* Kimg = Vimg + 256 * 72; const LAS float* tab = (const LAS float*)(lds + b * BUFB + 2 * VB);
        const int ql = 16 * w + li, qtok = seq0 + (u0 + ql) * d + rho, ccfg = cfg, ch = h, cu0 = u0, cL = L;
        f32x4 sc[9];
#pragma unroll
        for (int tt = 0; tt < 9; ++tt) { f32x4 sv = {0.f, 0.f, 0.f, 0.f}; sv = mfma32(ld_contig(Kimg, 72, (w + tt) * 16, 0, lane), qf0, sv); sv = mfma32(ld_contig(Kimg, 72, (w + tt) * 16, 32, lane), qf1, sv); sc[tt] = sv; }
        __builtin_amdgcn_sched_barrier(0);
        const bool has_next = iu + wpx < UPX;
        if (has_next) { DA_DECODE(xcd * UPX + iu + wpx); DA_LOAD(); }
        __builtin_amdgcn_sched_barrier(0);
        { const LAS float* tl = tab + 16 + gq * 4 - li;
#pragma unroll
        for (int tt = 0; tt < 9; ++tt)
#pragma unroll
            for (int j = 0; j < 4; ++j) sc[tt][j] += tl[tt * 16 + j]; }
        if (cu0 == 0 || cu0 + 128 == cL) {
#pragma unroll
            for (int tt = 0; tt < 9; ++tt)
#pragma unroll
                for (int j = 0; j < 4; ++j) { const int ukj = cu0 - 64 + (w + tt) * 16 + gq * 4 + j; sc[tt][j] = (ukj >= 0 && ukj < cL) ? sc[tt][j] : -1e30f; } }
        float m = -3e38f;
#pragma unroll
        for (int tt = 0; tt < 9; ++tt)
#pragma unroll
            for (int j = 0; j < 4; ++j) m = fmaxf(m, sc[tt][j]);
        m = fmaxf(m, __shfl_xor(m, 16)); m = fmaxf(m, __shfl_xor(m, 32));
        float sum = 0.f;
#pragma unroll
        for (int tt = 0; tt < 9; ++tt)
#pragma unroll
            for (int j = 0; j < 4; ++j) { const float p = __expf(sc[tt][j] - m); sc[tt][j] = p; sum += p; }
        sum += __shfl_xor(sum, 16); sum += __shfl_xor(sum, 32);
        f32x4 o[4];
#pragma unroll
        for (int dt = 0; dt < 4; ++dt) o[dt] = (f32x4){0.f, 0.f, 0.f, 0.f};
#pragma unroll
        for (int tt = 0; tt < 9; ++tt) { const int krow = (w + tt) * 16; const s16x4 pb = pack4(sc[tt]);
#pragma unroll
            for (int dt = 0; dt < 4; ++dt) o[dt] = mfma16(ld_tr4(Vimg, 72, krow, dt * 16, lane), pb, o[dt]); }
        const float inv = 1.0f / sum;
#pragma unroll
        for (int dt = 0; dt < 4; ++dt) { uint2 wv; wv.x = pk(o[dt][0] * inv, o[dt][1] * inv); wv.y = pk(o[dt][2] * inv, o[dt][3] * inv);
            *(uint2*)(DAO + ((size_t)ccfg * MG + qtok) * 256 + ch * 64 + dt * 16 + gq * 4) = wv; }
        if (gq == 0) DALSE[((size_t)ccfg * MG + qtok) * 4 + ch] = m + __logf(sum);
        if (has_next) DA_STAGE(b ^ 1);
        __syncthreads();
    }
#undef DA_DECODE
#undef DA_LOAD
#undef DA_STAGE
}
DI void phase_da_combine(const bf16* DAO, const float* DALSE, bf16* MIX, int bid, int nb, int tid) {
    for (int idx = bid * NT + tid; idx < MG * 32; idx += nb * NT) {
        const int tok = idx >> 5, sub = idx & 31, h = sub >> 3;
        const float l0 = DALSE[((size_t)0 * MG + tok) * 4 + h], l1 = DALSE[((size_t)1 * MG + tok) * 4 + h], l2 = DALSE[((size_t)2 * MG + tok) * 4 + h];
        const float m = fmaxf(l0, fmaxf(l1, l2)); float w0 = __expf(l0 - m), w1 = __expf(l1 - m), w2 = __expf(l2 - m); const float inv = 1.0f / (w0 + w1 + w2); w0 *= inv; w1 *= inv; w2 *= inv;
        const uint4 a = *(const uint4*)(DAO + ((size_t)0 * MG + tok) * 256 + sub * 8), b = *(const uint4*)(DAO + ((size_t)1 * MG + tok) * 256 + sub * 8), cc = *(const uint4*)(DAO + ((size_t)2 * MG + tok) * 256 + sub * 8);
        uint4 o;
        o.x = pk(w0 * bflo(a.x) + w1 * bflo(b.x) + w2 * bflo(cc.x), w0 * bfhi(a.x) + w1 * bfhi(b.x) + w2 * bfhi(cc.x));
        o.y = pk(w0 * bflo(a.y) + w1 * bflo(b.y) + w2 * bflo(cc.y), w0 * bfhi(a.y) + w1 * bfhi(b.y) + w2 * bfhi(cc.y));
        o.z = pk(w0 * bflo(a.z) + w1 * bflo(b.z) + w2 * bflo(cc.z), w0 * bfhi(a.z) + w1 * bfhi(b.z) + w2 * bfhi(cc.z));
        o.w = pk(w0 * bflo(a.w) + w1 * bflo(b.w) + w2 * bflo(cc.w), w0 * bfhi(a.w) + w1 * bfhi(b.w) + w2 * bfhi(cc.w));
        *(uint4*)(MIX + (size_t)tok * DM + 256 + sub * 8) = o;
    }
}

DI void phase_hg1(const Ctx& c, LAS unsigned char* lds, int g, int l, const bf16* PROJ, bf16* ST, bf16* RT, float* RDEC, float* GC, bf16* KT1, bf16* QTB, int bid, int nb, int tid) {
    const int ncs = g < 2 ? 256 : 64, rps = ncs / 8;
    constexpr int HB = 2 * 64 * 136 * 2 + 4096 + 2 * 64 * 136 * 2 + 1024;
    const float* LB = (const float*)(c.ws + WS_LB);
    const int w = tid >> 6, lane = tid & 63, gq = lane >> 4, li = lane & 15, k2 = tid & 63, seg = tid >> 6;
    unsigned qq[8]; u32x4 zch[2], qch[2], vch[2];
#define HG1_LOAD(UNIT, ZCH, QCH, VCH) do { const int dir_ = (UNIT) & 1, h_ = ((UNIT) >> 1) & 3, t0_ = ((UNIT) >> 3) * 64; const int zb_ = (dir_ ? C_CFB : C_CFF) + h_ * 128, qb_ = C_CQ + h_ * 128; \
        _Pragma("unroll") for (int i_ = 0; i_ < 2; ++i_) { const int ch_ = tid + i_ * NT, row_ = ch_ >> 4, sub_ = ch_ & 15; const bf16* rp_ = PROJ + (size_t)(t0_ + row_) * NIN + sub_ * 8; \
            ZCH[i_] = *(const u32x4*)(rp_ + zb_); QCH[i_] = *(const u32x4*)(rp_ + qb_); VCH[i_] = *(const u32x4*)(rp_ + C_CI + h_ * 128); } } while (0)
#define HG1_RAW(SET, ZCH, QCH) do { LAS bf16* rz_ = (LAS bf16*)(lds + (SET) * HB + 2 * 64 * 136 * 2 + 4096); \
        _Pragma("unroll") for (int i_ = 0; i_ < 2; ++i_) { const int ch_ = tid + i_ * NT, row_ = ch_ >> 4, sub_ = ch_ & 15; *(LAS u32x4*)(rz_ + row_ * 136 + sub_ * 8) = ZCH[i_]; *(LAS u32x4*)(rz_ + 64 * 136 + row_ * 136 + sub_ * 8) = QCH[i_]; } } while (0)
#define HG1_UNIT(R, J, U) do { const int combo_ = (R) / rps, blk_ = (R) % rps, s_ = combo_ >> 3, hd_ = combo_ & 7, p_ = blk_ * 8 + (J), cs_ = (hd_ & 1) ? ncs - 1 - p_ : p_; \
        U = (((s_ * ncs + cs_) * 4 + (hd_ >> 1)) * 2) + (hd_ & 1); } while (0)
    int unit = 0;
    if (bid < 256) { HG1_UNIT(bid, 0, unit); HG1_LOAD(unit, zch, qch, vch); HG1_RAW(0, zch, qch); }
    __syncthreads();
    for (int r = bid; r < 256; r += nb) {
      f32x4 Sloc[2][4];
#pragma unroll
      for (int a = 0; a < 2; ++a)
#pragma unroll
          for (int b = 0; b < 4; ++b) Sloc[a][b] = (f32x4){0.f, 0.f, 0.f, 0.f};
      float lrun0 = 0.f, lrun1 = 0.f;
      for (int jr = 0; jr < 8; ++jr) {
        HG1_UNIT(r, jr, unit);
        LAS unsigned char* lb_ = lds + (jr & 1) * HB;
        LAS bf16* K1 = (LAS bf16*)lb_;
        LAS bf16* Vimg = K1 + 64 * 136;
        LAS float* tot = (LAS float*)(lb_ + 2 * 64 * 136 * 2);
        LAS bf16* KS = (LAS bf16*)(lb_ + 2 * 64 * 136 * 2 + 4096);
        LAS bf16* QS = KS + 64 * 136;
        LAS float* asq = (LAS float*)(lb_ + 2 * 64 * 136 * 2 + 4096 + 2 * 64 * 136 * 2);
        const int dir = unit & 1, h = (unit >> 1) & 3;
        const float lb0 = LB[(dir * 2 + l) * 512 + h * 128 + 2 * k2], lb1 = LB[(dir * 2 + l) * 512 + h * 128 + 2 * k2 + 1];
        float pf0[8], pf1[8], fv0[8], fv1[8]; float p0 = 1.f, p1 = 1.f;
#pragma unroll
        for (int e = 0; e < 8; ++e) { const int tau_ = dir ? seg * 8 + 7 - e : seg * 8 + e; const unsigned zzv = *(const LAS unsigned*)(KS + tau_ * 136 + 2 * k2); qq[e] = *(const LAS unsigned*)(QS + tau_ * 136 + 2 * k2);
            const float z0 = bflo(zzv), z1 = bfhi(zzv);
            const float ez0 = __expf(-z0), ez1 = __expf(-z1), s0 = __builtin_amdgcn_rcpf(1.0f + ez0), s1_ = __builtin_amdgcn_rcpf(1.0f + ez1);
            const float f0 = lb0 + (1.0f - lb0) * s0, f1 = lb1 + (1.0f - lb1) * s1_;
            fv0[e] = f0; fv1[e] = f1; p0 *= f0; p1 *= f1; pf0[e] = p0; pf1[e] = p1; }
        const float run0 = __builtin_amdgcn_logf(fmaxf(p0, 1e-37f)) * 0.69314718056f, run1 = __builtin_amdgcn_logf(fmaxf(p1, 1e-37f)) * 0.69314718056f;
        tot[seg * 128 + 2 * k2] = run0; tot[seg * 128 + 2 * k2 + 1] = run1;
#pragma unroll
        for (int i = 0; i < 2; ++i) { const int ch = tid + i * NT, row = ch >> 4, sub = ch & 15; *(LAS u32x4*)(Vimg + row * 136 + sub * 8) = vch[i]; }
        __syncthreads();
        u32x4 zchn[2], qchn[2], vchn[2];
        int nunit = -1; if (jr < 7) HG1_UNIT(r, jr + 1, nunit); else if (r + nb < 256) HG1_UNIT(r + nb, 0, nunit);
        if (nunit >= 0) HG1_LOAD(nunit, zchn, qchn, vchn);
        float off0 = 0.f, off1 = 0.f, total0 = 0.f, total1 = 0.f;
#pragma unroll
        for (int s2 = 0; s2 < 8; ++s2) { const float a0 = tot[s2 * 128 + 2 * k2], a1 = tot[s2 * 128 + 2 * k2 + 1]; total0 += a0; total1 += a1;
            const bool before = dir ? (s2 > seg) : (s2 < seg); off0 += before ? a0 : 0.f; off1 += before ? a1 : 0.f; }
        bf16* kt1 = KT1 + (size_t)unit * 8192; bf16* qtb = QTB + (size_t)unit * 8192;
        const float ch0 = __expf(-0.5f * total0), ch1 = __expf(-0.5f * total1);
        const float eo0 = __expf(off0), eo1 = __expf(off1), er0 = __expf(total0 - off0 - run0), er1 = __expf(total1 - off1 - run1);
        float sf0 = 1.f, sf1 = 1.f;
#pragma unroll
        for (int e = 7; e >= 0; --e) { const int tau = dir ? seg * 8 + 7 - e : seg * 8 + e;
            const float ka = (1.0f - fv0[e]) * (er0 * sf0), kb = (1.0f - fv1[e]) * (er1 * sf1), qa = silu_f(bflo(qq[e])) * (eo0 * pf0[e]), qb = silu_f(bfhi(qq[e])) * (eo1 * pf1[e]);
            sf0 *= fv0[e]; sf1 *= fv1[e];
            *(LAS unsigned*)(K1 + tau * 136 + 2 * k2) = pk(ka, kb); *(LAS unsigned*)(KS + tau * 136 + 2 * k2) = pk(ka * ch0, kb * ch1);
            *(LAS unsigned*)(QS + tau * 136 + 2 * k2) = pk(qa * ch0, qb * ch1); }
        if (seg == 0) { *(LAS f32x4*)(asq + 4 * k2) = (f32x4){__expf(total0), __expf(0.5f * total0), __expf(total1), __expf(0.5f * total1)};
            *(float2*)(GC + (size_t)unit * 128 + 2 * k2) = make_float2(__expf(0.5f * total0 + lrun0), __expf(0.5f * total1 + lrun1)); }
        lrun0 += total0; lrun1 += total1;
        __syncthreads();
#pragma unroll
        for (int i = 0; i < 4; ++i) { const int f = w * 4 + i, st = (f >> 2) & 3, ks = f & 3;
            const bf16x8 v = ld_contig(f < 16 ? KS : QS, 136, st * 16, ks * 32, lane);
            *(bf16x8*)((f < 16 ? kt1 : qtb) + ((f & 15) * 64 + lane) * 8) = v; }
        const int kt0 = (w >> 1) * 2, vt0 = (w & 1) * 4;
        f32x4 acc[2][4];
#pragma unroll
        for (int a = 0; a < 2; ++a)
#pragma unroll
            for (int b = 0; b < 4; ++b) acc[a][b] = (f32x4){0.f, 0.f, 0.f, 0.f};
#pragma unroll
        for (int ks = 0; ks < 2; ++ks) { bf16x8 af[2], bfv[4];
#pragma unroll
            for (int a = 0; a < 2; ++a) af[a] = ld_tr8(K1, 136, ks * 32, (kt0 + a) * 16, lane);
#pragma unroll
            for (int b = 0; b < 4; ++b) bfv[b] = ld_tr8(Vimg, 136, ks * 32, (vt0 + b) * 16, lane);
#pragma unroll
            for (int a = 0; a < 2; ++a)
#pragma unroll
                for (int b = 0; b < 4; ++b) acc[a][b] = mfma32(af[a], bfv[b], acc[a][b]); }
#pragma unroll
        for (int a = 0; a < 2; ++a) { const int kb_ = (kt0 + a) * 16 + gq * 4; const f32x4 as0 = *(const LAS f32x4*)(asq + 2 * kb_), as1 = *(const LAS f32x4*)(asq + 2 * kb_ + 4);
#pragma unroll
            for (int b = 0; b < 4; ++b) { const f32x4 x = Sloc[a][b]; uint2 wv; wv.x = pk(x[0] * as0[1], x[1] * as0[3]); wv.y = pk(x[2] * as1[1], x[3] * as1[3]);
                *(uint2*)(ST + (size_t)unit * 16384 + fr_off((vt0 + b) * 16 + li, kb_)) = wv;
                Sloc[a][b] = (f32x4){as0[0] * x[0] + acc[a][b][0], as0[2] * x[1] + acc[a][b][1], as1[0] * x[2] + acc[a][b][2], as1[2] * x[3] + acc[a][b][3]}; } }
        if (jr == 7) {
#pragma unroll
            for (int a = 0; a < 2; ++a)
#pragma unroll
                for (int b = 0; b < 4; ++b) { const f32x4 x = Sloc[a][b]; uint2 wv; wv.x = pk(x[0], x[1]); wv.y = pk(x[2], x[3]);
                    *(uint2*)(RT + (size_t)r * 16384 + fr_off((vt0 + b) * 16 + li, (kt0 + a) * 16 + gq * 4)) = wv; }
            if (seg == 0) *(float4*)(RDEC + (size_t)r * 256 + 4 * k2) = make_float4(__expf(lrun0), __expf(lrun1), 1.0f, 1.0f);
        }
        if (nunit >= 0) HG1_RAW((jr + 1) & 1, zchn, qchn);
        vch[0] = vchn[0]; vch[1] = vchn[1];
        __syncthreads();
      }
    }
    __syncthreads();
#undef HG1_UNIT
#undef HG1_RAW
#undef HG1_LOAD
}
DI void phase_rscan(int g, bf16* RT, const float* RDEC, int bid, int nb, int tid) {
    const int rps = g < 2 ? 32 : 8, combos = g < 2 ? 8 : 32, ntasks = combos * 8192;
    for (int task = bid * NT + tid; task < ntasks; task += nb * NT) {
        const int e = task & 8191, combo = task >> 13;
        const int k = (((e >> 8) & 3) << 5) + (((e >> 6) & 3) << 3) + ((2 * e) & 7);
        bf16* sp = RT + (size_t)(combo * rps) * 16384 + 2 * e;
        const float* ap = RDEC + (size_t)(combo * rps) * 256 + 2 * k;
        float S0 = 0.f, S1 = 0.f;
        for (int st0 = 0; st0 < rps; st0 += 8) {
            unsigned u[8]; float4 a[8];
#pragma unroll
            for (int j = 0; j < 8; ++j) { u[j] = *(const unsigned*)(sp + (size_t)j * 16384); a[j] = *(const float4*)(ap + (size_t)j * 256); }
#pragma unroll
            for (int j = 0; j < 8; ++j) { *(unsigned*)(sp + (size_t)j * 16384) = pk(S0, S1); S0 = a[j].x * S0 + bflo(u[j]); S1 = a[j].y * S1 + bfhi(u[j]); }
            sp += 8 * 16384; ap += 8 * 256;
        }
    }
}
DI void phase_scan(int g, bf16* ST, const float* ADEC, const float* ASQ, int bid, int nb, int tid) {
    const int Tg = g < 2 ? 16384 : 4096, nseq = g < 2 ? 1 : 4, ncs = Tg / 64, ntasks = nseq * 8 * 8192;
    for (int task = bid * NT + tid; task < ntasks; task += nb * NT) {
        const int e = task & 8191, hd = (task >> 13) & 7, s = task >> 16, h = hd >> 1, dir = hd & 1;
        const int k = (((e >> 8) & 3) << 5) + (((e >> 6) & 3) << 3) + ((2 * e) & 7);
        const int c0 = s * ncs + (dir ? ncs - 1 : 0);
        const long cst = dir ? -8 : 8;
        bf16* sp = ST + ((size_t)(c0 * 4 + h) * 2 + dir) * 16384 + 2 * e;
        const float* ap = ADEC + ((size_t)(c0 * 4 + h) * 2 + dir) * 256 + 2 * k;
        float S0 = 0.f, S1 = 0.f;
        for (int st0 = 0; st0 < ncs; st0 += 32) {
            unsigned u[32]; float4 a[32];
#pragma unroll
            for (int j = 0; j < 32; ++j) { u[j] = *(const unsigned*)(sp + (long)j * cst * 16384); a[j] = *(const float4*)(ap + (long)j * cst * 256); }
#pragma unroll
            for (int j = 0; j < 32; ++j) { *(unsigned*)(sp + (long)j * cst * 16384) = pk(S0 * a[j].z, S1 * a[j].w); S0 = a[j].x * S0 + bflo(u[j]); S1 = a[j].y * S1 + bfhi(u[j]); }
            sp += 32 * cst * 16384; ap += 32 * cst * 256;
        }
    }
}
DI bf16x8 scale8(bf16x8 v, const f32x4 c0, const f32x4 c1) {
    const u32x4 w = __builtin_bit_cast(u32x4, v); u32x4 o;
    o[0] = pk(bflo(w[0]) * c0[0], bfhi(w[0]) * c0[1]); o[1] = pk(bflo(w[1]) * c0[2], bfhi(w[1]) * c0[3]);
    o[2] = pk(bflo(w[2]) * c1[0], bfhi(w[2]) * c1[1]); o[3] = pk(bflo(w[3]) * c1[2], bfhi(w[3]) * c1[3]);
    return __builtin_bit_cast(bf16x8, o);
}
DI void phase_hg3(const Ctx& c, LAS unsigned char* lds, int g, int l, const bf16* PROJ, const bf16* ST, const bf16* RT, const float* GC, const bf16* KT1, const bf16* QTB, bf16* MIX, int bid, int nb, int tid) {
    const int ncs = g < 2 ? 256 : 64, rps = ncs / 8;
    const int w = tid >> 6, hh = w >> 2, tt = w & 3, lane = tid & 63, gq = lane >> 4, li = lane & 15;
    LAS bf16* Vimg = (LAS bf16*)lds + hh * 64 * 136;
    u32x4 vpre[4];
#define HG3_VPREFETCH(UNIT) do { const int hp_ = (UNIT) & 1, t0_ = ((UNIT) >> 1) * 64; \
        _Pragma("unroll") for (int i_ = 0; i_ < 4; ++i_) { const int ch_ = tid + i_ * NT, hv_ = ch_ >> 10, row_ = (ch_ >> 4) & 63, sub_ = ch_ & 15; \
            vpre[i_] = *(const u32x4*)(PROJ + (size_t)(t0_ + row_) * NIN + C_CI + (hp_ * 2 + hv_) * 128 + sub_ * 8); } } while (0)
    if (bid < 512) HG3_VPREFETCH(bid);
    for (int unit = bid; unit < 512; unit += nb) {
        const int hp = unit & 1, cgk = unit >> 1, h = hp * 2 + hh, t0 = cgk * 64;
#pragma unroll
        for (int i = 0; i < 4; ++i) { const int ch = tid + i * NT, hv = ch >> 10, row = (ch >> 4) & 63, sub = ch & 15;
            *(LAS u32x4*)((LAS bf16*)lds + hv * 64 * 136 + row * 136 + sub * 8) = vpre[i]; }
        __syncthreads();
        if (unit + nb < 512) HG3_VPREFETCH(unit + nb);
        f32x4 o[8];
#pragma unroll
        for (int vt = 0; vt < 8; ++vt) o[vt] = (f32x4){0.f, 0.f, 0.f, 0.f};
        for (int dir = 0; dir < 2; ++dir) {
            const size_t su = (size_t)(cgk * 4 + h) * 2 + dir;
            bf16x8 qt[4], kr[4][4], sa[2][8];
            const int nst = dir ? 4 - tt : tt + 1, st0 = dir ? tt : 0;
#pragma unroll
            for (int ks = 0; ks < 4; ++ks) qt[ks] = *(const bf16x8*)(QTB + su * 8192 + ((tt * 4 + ks) * 64 + lane) * 8);
#pragma unroll
            for (int si = 0; si < 4; ++si) { const int st = (st0 + si) & 3;
#pragma unroll
                for (int ks = 0; ks < 4; ++ks) kr[si][ks] = *(const bf16x8*)(KT1 + su * 8192 + ((st * 4 + ks) * 64 + lane) * 8); }
#pragma unroll
            for (int vt = 0; vt < 8; ++vt) sa[0][vt] = *(const bf16x8*)(ST + su * 16384 + ((vt * 4) * 64 + lane) * 8);
            __builtin_amdgcn_sched_barrier(0);
#pragma unroll
            for (int si = 0; si < 4; ++si) {
                if (si < nst) { const int st = st0 + si;
                    f32x4 acc = {0.f, 0.f, 0.f, 0.f};
#pragma unroll
                    for (int ks = 0; ks < 4; ++ks) acc = mfma32(kr[si][ks], qt[ks], acc);
#pragma unroll
                    for (int j = 0; j < 4; ++j) { const int sg = st * 16 + gq * 4 + j, ta = tt * 16 + li; const bool keep = dir ? (sg >= ta) : (sg <= ta); acc[j] = keep ? acc[j] : 0.f; }
                    const s16x4 pb = pack4(acc);
#pragma unroll
                    for (int vt = 0; vt < 8; ++vt) o[vt] = mfma16(ld_tr4(Vimg, 136, st * 16, vt * 16, lane), pb, o[vt]);
                }
            }
#pragma unroll
            for (int ks = 0; ks < 4; ++ks) {
                if (ks < 3) {
#pragma unroll
                    for (int vt = 0; vt < 8; ++vt) sa[(ks + 1) & 1][vt] = *(const bf16x8*)(ST + su * 16384 + ((vt * 4 + ks + 1) * 64 + lane) * 8); }
#pragma unroll
                for (int vt = 0; vt < 8; ++vt) o[vt] = mfma32(sa[ks & 1][vt], qt[ks], o[vt]);
            }
            { const int sq_ = cgk / ncs, cs = cgk - sq_ * ncs, p = dir ? ncs - 1 - cs : cs, blk = p >> 3;
              if (blk > 0) { const size_t rr = (size_t)((sq_ * 8 + h * 2 + dir) * rps + blk);
#pragma unroll
                for (int ks = 0; ks < 4; ++ks) { const float* gp = GC + su * 128 + ks * 32 + gq * 8; const bf16x8 q2 = scale8(qt[ks], *(const f32x4*)gp, *(const f32x4*)(gp + 4));
#pragma unroll
                    for (int vt = 0; vt < 8; ++vt) sa[0][vt] = *(const bf16x8*)(RT + rr * 16384 + ((vt * 4 + ks) * 64 + lane) * 8);
#pragma unroll
                    for (int vt = 0; vt < 8; ++vt) o[vt] = mfma32(sa[0][vt], q2, o[vt]); } } }
        }
        float ssq = 0.f;
#pragma unroll
        for (int vt = 0; vt < 8; ++vt)
#pragma unroll
            for (int j = 0; j < 4; ++j) ssq += o[vt][j] * o[vt][j];
        ssq += __shfl_xor(ssq, 16); ssq += __shfl_xor(ssq, 32);
        const float rinv = rsqrtf(ssq * (1.0f / 128.0f) + EPS);
        const int tok = t0 + tt * 16 + li;
#pragma unroll
        for (int vt = 0; vt < 8; ++vt) { const int v = vt * 16 + gq * 4; const float4 gn = *(const float4*)(c.hg_norm_g + l * 128 + v);
            const uint2 gw = *(const uint2*)(PROJ + (size_t)tok * NIN + C_CG + h * 128 + v);
            uint2 wv; wv.x = pk(o[vt][0] * rinv * gn.x * silu_f(bflo(gw.x)), o[vt][1] * rinv * gn.y * silu_f(bfhi(gw.x)));
            wv.y = pk(o[vt][2] * rinv * gn.z * silu_f(bflo(gw.y)), o[vt][3] * rinv * gn.w * silu_f(bfhi(gw.y)));
            *(uint2*)(MIX + (size_t)tok * DM + 512 + h * 128 + v) = wv; }
        __syncthreads();
    }
}
#undef HG3_VPREFETCH

DI float gelu_t(float x) { const float u = 0.7978845608028654f * (x + 0.044715f * x * x * x); return x / (1.0f + __expf(-2.0f * u)); }
DI void phase_conv(const Ctx& c, int g, int l, const bf16* GU, bf16* ACT, int bid, int nb, int tid) {
    const int Tg = g < 2 ? 16384 : 4096;
    for (int idx = bid * NT + tid; idx < (MG / 8) * 352; idx += nb * NT) {
        const int run = idx / 352, j = (idx - run * 352) * 8, pn = j >> 7, jj = j & 127, gcol = pn * 256 + jj, tok0 = run * 8, tq = tok0 % Tg;
        const bf16* gp = GU + (size_t)tok0 * NUP + gcol;
        u32x4 gr[10], up[8];
#pragma unroll
        for (int r = 0; r < 8; ++r) { gr[r + 1] = *(const u32x4*)(gp + (size_t)r * NUP); up[r] = *(const u32x4*)(gp + (size_t)r * NUP + 128); }
        gr[0] = (u32x4){0u, 0u, 0u, 0u}; gr[9] = (u32x4){0u, 0u, 0u, 0u};
        if (tq > 0) gr[0] = *(const u32x4*)(gp - NUP);
        if (tq + 8 < Tg) gr[9] = *(const u32x4*)(gp + (size_t)8 * NUP);
        const float* cw = c.conv_w + (size_t)l * 3 * DFF + j; const float* cb = c.conv_b + (size_t)l * DFF + j;
        float w0[8], w1[8], w2[8], bb[8];
        *(float4*)&w0[0] = *(const float4*)cw; *(float4*)&w0[4] = *(const float4*)(cw + 4);
        *(float4*)&w1[0] = *(const float4*)(cw + DFF); *(float4*)&w1[4] = *(const float4*)(cw + DFF + 4);
        *(float4*)&w2[0] = *(const float4*)(cw + 2 * DFF); *(float4*)&w2[4] = *(const float4*)(cw + 2 * DFF + 4);
        *(float4*)&bb[0] = *(const float4*)cb; *(float4*)&bb[4] = *(const float4*)(cb + 4);
#pragma unroll
        for (int r = 0; r < 8; ++r) { u32x4 o;
#pragma unroll
            for (int i = 0; i < 4; ++i) {
                const float xa = w0[2 * i] * bflo(gr[r][i]) + w1[2 * i] * bflo(gr[r + 1][i]) + w2[2 * i] * bflo(gr[r + 2][i]) + bb[2 * i];
                const float xb = w0[2 * i + 1] * bfhi(gr[r][i]) + w1[2 * i + 1] * bfhi(gr[r + 1][i]) + w2[2 * i + 1] * bfhi(gr[r + 2][i]) + bb[2 * i + 1];
                o[i] = pk(gelu_t(xa) * bflo(up[r][i]), gelu_t(xb) * bfhi(up[r][i])); }
            *(u32x4*)(ACT + (size_t)(tok0 + r) * DFF + j) = o; }
    }
}

#define XB_TMO      128
#define XB_XCNT(j)  (256  + 64 * (j))
#define XB_XSUB(j)  (1280 + 64 * (j))
#define XB_XGEN(j)  (2304 + 64 * (j))
#define XB_TOP      3328
#define XB_TOPGEN   3392
#define XCD_BAR_WORDS 3456
#define XB_SPIN_CAP (1u << 18)
constexpr size_t WS_BAR = 65536, WS_SSQ1 = 131072, WS_SSQ2 = 131072 + 262144, WS_H2 = 89 * MiB;
DI unsigned xb_ld(unsigned* p)              { return __hip_atomic_load(p, __ATOMIC_RELAXED, __HIP_MEMORY_SCOPE_AGENT); }
DI unsigned xb_add(unsigned* p, unsigned v) { return __hip_atomic_fetch_add(p, v, __ATOMIC_RELAXED, __HIP_MEMORY_SCOPE_AGENT); }
DI unsigned xb_xcc_id() { return (unsigned)__builtin_amdgcn_s_getreg((3 << 11) | 20) & 0xFu; }
#define XB_SPIN(cond, bar) do { unsigned _sp = 0; while (cond) { __builtin_amdgcn_s_sleep(1); \
    if ((++_sp & 255u) == 0u) { if (xb_ld(&(bar)[XB_TMO])) break; if (_sp > XB_SPIN_CAP) { atomicAdd(&(bar)[XB_TMO], 1u); break; } } } } while (0)
struct XcdBarrier { unsigned* bar; unsigned x; volatile LAS unsigned* st; };
DI XcdBarrier xcd_barrier_post(unsigned* bar, volatile LAS unsigned* st) {
    XcdBarrier b; b.bar = bar; b.x = xb_xcc_id(); b.st = st;
    if (threadIdx.x == 0) (void)xb_add(&bar[XB_XCNT(b.x)], 1u);
    return b;
}
DI void xcd_barrier_complete(unsigned* bar, unsigned x, unsigned& nloc, unsigned& nx) {
    const unsigned G = gridDim.x * gridDim.y * gridDim.z;
    unsigned sum, cnt, mine, sp = 0u;
    for (;;) {
        sum = 0u; cnt = 0u; mine = 0u;
#pragma unroll
        for (unsigned j = 0; j < 16; ++j) { const unsigned c = xb_ld(&bar[XB_XCNT(j)]); sum += c; cnt += (c > 0u) ? 1u : 0u; mine = (j == x) ? c : mine; }
        if (sum == G) break;
        __builtin_amdgcn_s_sleep(1);
        if ((++sp & 255u) == 0u) { if (xb_ld(&bar[XB_TMO])) break; if (sp > XB_SPIN_CAP) { atomicAdd(&bar[XB_TMO], 1u); break; } }
    }
    nloc = mine > 0u ? mine : 1u; nx = cnt > 0u ? cnt : 1u;
}
DI void xcd_barrier(const XcdBarrier& b) {
    asm volatile("s_waitcnt vmcnt(0)" ::: "memory");
    __syncthreads();
    if (threadIdx.x == 0) {
        unsigned* bar = b.bar;
        __builtin_amdgcn_s_waitcnt(0);
        unsigned nloc = b.st[0], nx = b.st[1];
        if (nloc == 0u) { xcd_barrier_complete(bar, b.x, nloc, nx); b.st[0] = nloc; b.st[1] = nx; }
        const unsigned old = xb_add(&bar[XB_XSUB(b.x)], 1u);
        const unsigned gen = old / nloc;
        if (old + 1u == (gen + 1u) * nloc) {
            __builtin_amdgcn_fence(__ATOMIC_RELEASE, "agent");
            asm volatile("s_waitcnt vmcnt(0)" ::: "memory");
            const unsigned og = xb_add(&bar[XB_TOP], 1u);
            const unsigned tg = og / nx;
            if (og + 1u == (tg + 1u) * nx) xb_add(&bar[XB_TOPGEN], 1u);
            else XB_SPIN(xb_ld(&bar[XB_TOPGEN]) == tg, bar);
            __builtin_amdgcn_fence(__ATOMIC_ACQUIRE, "agent");
            xb_add(&bar[XB_XGEN(b.x)], 1u);
            asm volatile("s_waitcnt vmcnt(0)" ::: "memory");
        } else {
            XB_SPIN(xb_ld(&bar[XB_XGEN(b.x)]) == gen, bar);
            __builtin_amdgcn_fence(__ATOMIC_ACQUIRE, "agent");
            asm volatile("s_waitcnt vmcnt(0)" ::: "memory");
        }
    }
    __syncthreads();
}

template <class Epi> DI void run_gemm(LAS unsigned char* lds, const bf16* A, const bf16* Bt, int N, int K, const Epi& E, int bid, int nb, int tid, int a_rows = 256, int mrows = MG) {
    pg8::Gemm gm{A, Bt, mrows, N, K, a_rows}; pg8::StaticOrder S; S.init(mrows, N, nb, bid);
    pg8::gemm_phase<Epi, pg8::StaticOrder, true, true>((PG8_LAS unsigned char*)lds, gm, S, E, tid);
}
#define LAUNDER() asm volatile("" : "+v"(tid), "+s"(bid), "+s"(nb))
#define GSYNC() xcd_barrier(xbar)
#define CGSYNC() do { asm volatile("s_waitcnt vmcnt(0) lgkmcnt(0)" ::: "memory"); grid.sync(); } while (0)
#ifndef REP_NA
#define REP_NA 1
#endif
#ifndef REP_DA
#define REP_DA 1
#endif
#ifndef REP_HG1
#define REP_HG1 1
#endif
#ifndef REP_HG3
#define REP_HG3 1
#endif
#ifndef REP_GIN
#define REP_GIN 1
#endif
#ifndef REP_GUP
#define REP_GUP 1
#endif
#ifndef REP_CONV
#define REP_CONV 1
#endif
#ifndef REP_NORM
#define REP_NORM 1
#endif
__global__ void __launch_bounds__(NT, 2) mega_fwd(Ctx c) {
    extern __shared__ __attribute__((aligned(16))) unsigned char smem[];
    LAS unsigned char* lds = (LAS unsigned char*)smem;
    cg::grid_group grid = cg::this_grid();
    int tid = threadIdx.x, bid = blockIdx.x, nb = gridDim.x;
    unsigned char* ws = c.ws;
    bf16* H = (bf16*)(ws + WS_H); bf16* PROJ = (bf16*)(ws + WS_PROJ); bf16* ST = (bf16*)(ws + WS_ST); bf16* GU = (bf16*)(ws + WS_GU); float* ADEC = (float*)(ws + WS_QHB);
    bf16* DAO = (bf16*)(ws + WS_DAO); float* DALSE = (float*)(ws + WS_DALSE); bf16* ACT = (bf16*)(ws + WS_ACT); bf16* KT1 = (bf16*)(ws + WS_KT1); bf16* QHB = (bf16*)(ws + WS_QHB); bf16* QTB = (bf16*)(ws + WS_QTB); bf16* RT = (bf16*)(ws + WS_QHB + 4 * MiB); float* RDEC = (float*)(ws + WS_QHB + 16 * MiB); float* GC = (float*)(ws + WS_QHB + 18 * MiB); bf16* H2 = (bf16*)(ws + WS_H2); bf16* MIX = (bf16*)(ws + WS_ACT);
     float* SSQ1 = (float*)(ws + WS_SSQ1); float* SSQ2 = (float*)(ws + WS_SSQ2); float* ATOT = (float*)(ws + WS_ATOT);
    volatile LAS unsigned* xst = (volatile LAS unsigned*)(lds + LDS_BYTES - 16);
    if (tid < 4) xst[tid] = 0u;
    __syncthreads();
    const XcdBarrier xbar = xcd_barrier_post((unsigned*)(ws + WS_BAR), xst);
    LAUNDER(); phase_prologue(c, lds, bid, nb, tid);
    LAUNDER(); phase_xcast(c.xp, H, SSQ1, bid, nb, tid);
    CGSYNC();
    for (int g = 0; g < 3; ++g) {
        const float* xin = g < 2 ? c.xp + (size_t)g * MG * DM : c.xs;
        float* xo = c.out + (size_t)g * MG * DM;
        for (int l = 0; l < 2; ++l) {
            for (int rep = 0; rep < REP_GIN; ++rep) { LAUNDER(); pg8::EpiIn E{PROJ, NIN, SSQ1, 1, {c.na_q_g + l * 64, c.na_k_g + l * 64, c.da_q_g + l * 64, c.da_k_g + l * 64}, (PG8_LAS float*)(lds + 131072)};
                run_gemm(lds, H, (const bf16*)(ws + WS_WIN + l * SZ_WIN), NIN, DM, E, bid, nb, tid); }
            GSYNC();
            for (int rep = 0; rep < REP_NA; ++rep) { LAUNDER(); phase_na(c, lds, g, l, PROJ, MIX, bid, nb, tid); }
            for (int rep = 0; rep < REP_DA; ++rep) { LAUNDER(); phase_da(c, lds, g, PROJ, DAO, DALSE, bid, nb, tid); }
            for (int rep = 0; rep < REP_HG1; ++rep) { LAUNDER(); phase_hg1(c, lds, g, l, PROJ, ST, RT, RDEC, GC, KT1, QTB, bid, nb, tid); }
            GSYNC();
            LAUNDER(); phase_rscan(g, RT, RDEC, bid, nb, tid);
            GSYNC();
            for (int rep = 0; rep < REP_HG3; ++rep) { LAUNDER(); phase_hg3(c, lds, g, l, PROJ, ST, RT, GC, KT1, QTB, MIX, bid, nb, tid); }
            LAUNDER(); phase_da_combine(DAO, DALSE, MIX, bid, nb, tid);
            GSYNC();
            LAUNDER();
            if (l == 0) { pg8::EpiResB<false, false> E{xin, H2, DM, SSQ2, (PG8_LAS float*)(lds + 131072)}; run_gemm(lds, MIX, (const bf16*)(ws + WS_WOUT + l * SZ_WOUT), DM, DM, E, bid, nb, tid); }
            else        { pg8::EpiResB<true, false> E{H, H2, DM, SSQ2, (PG8_LAS float*)(lds + 131072)}; run_gemm(lds, MIX, (const bf16*)(ws + WS_WOUT + l * SZ_WOUT), DM, DM, E, bid, nb, tid); }
            GSYNC();
            for (int rep = 0; rep < REP_GUP; ++rep) { LAUNDER(); pg8::EpiUp E{ACT, c.conv_w + (size_t)l * 3 * DFF, c.conv_b + (size_t)l * DFF, g < 2 ? 16384 : 4096, MG, DFF, (PG8_LAS float*)(lds + 131072), SSQ2};
                run_gemm(lds, H2 - DM, (const bf16*)(ws + WS_WUP + l * SZ_WUP), NUP, DM, E, bid, nb, tid, 254, 65 * 256); }
            GSYNC();
            LAUNDER();
            if (l == 0) { pg8::EpiResB<true, false> E{H2, H, DM, SSQ1, (PG8_LAS float*)(lds + 131072)}; run_gemm(lds, ACT, (const bf16*)(ws + WS_WDOWN + l * SZ_WDOWN), DM, DFF, E, bid, nb, tid); }
            else        { pg8::EpiResB<true, true> E{H2, xo, DM, nullptr, (PG8_LAS float*)(lds + 131072)}; run_gemm(lds, ACT, (const bf16*)(ws + WS_WDOWN + l * SZ_WDOWN), DM, DFF, E, bid, nb, tid); }
            if (l == 1 && g < 2) { LAUNDER(); phase_xcast(g == 0 ? c.xp + (size_t)MG * DM : c.xs, H, SSQ1, bid, nb, tid); }
            if (!(l == 1 && g == 2)) GSYNC();
        }
    }
}

extern "C" void kernel_launch(void* const* d_in, const int* in_sizes, int n_in, void* d_out, int out_size, void* d_ws, size_t ws_size, hipStream_t stream) {
    static int grid_blocks = 0;
    if (!grid_blocks) {
        if (hipFuncSetAttribute((const void*)mega_fwd, hipFuncAttributeMaxDynamicSharedMemorySize, LDS_BYTES) != hipSuccess) fprintf(stderr, "kernel_launch: hipFuncSetAttribute failed\n");
        int dev = 0, cus = 0, per_cu = 0;
        (void)hipGetDevice(&dev); (void)hipDeviceGetAttribute(&cus, hipDeviceAttributeMultiprocessorCount, dev);
        (void)hipOccupancyMaxActiveBlocksPerMultiprocessor(&per_cu, mega_fwd, NT, LDS_BYTES);
        if (per_cu < 1) per_cu = 1;
        grid_blocks = cus * per_cu;
        if (ws_size < WS_END) fprintf(stderr, "kernel_launch: workspace too small: %zu < %zu\n", ws_size, (size_t)WS_END);
    }
    Ctx c{};
    c.xp = (const float*)d_in[0]; c.xs = (const float*)d_in[1]; c.ln_mix_g = (const float*)d_in[2]; c.w_in = (const float*)d_in[3]; c.na_q_g = (const float*)d_in[4]; c.na_k_g = (const float*)d_in[5];
    c.na_rpb = (const float*)d_in[6]; c.da_q_g = (const float*)d_in[7]; c.da_k_g = (const float*)d_in[8]; c.t5_bias = (const float*)d_in[9]; c.hg_lb_logits = (const float*)d_in[10]; c.hg_norm_g = (const float*)d_in[11];
    c.w_out = (const float*)d_in[12]; c.ln_ffn_g = (const float*)d_in[13]; c.w_up = (const float*)d_in[14]; c.conv_w = (const float*)d_in[15]; c.conv_b = (const float*)d_in[16]; c.w_down = (const float*)d_in[17];
    c.out = (float*)d_out; c.ws = (unsigned char*)d_ws;
    if (hipMemsetAsync((char*)d_ws + WS_BAR, 0, XCD_BAR_WORDS * 4, stream) != hipSuccess) fprintf(stderr, "kernel_launch: memset of the barrier words failed\n");
    void* args[] = {&c};
    hipError_t e = hipLaunchCooperativeKernel((const void*)mega_fwd, dim3(grid_blocks), dim3(NT), args, LDS_BYTES, stream);
    if (e != hipSuccess) fprintf(stderr, "kernel_launch: cooperative launch failed: %s (grid %d)\n", hipGetErrorString(e), grid_blocks);
}
```

```cpp
#include <hip/hip_runtime.h>
#include <hip/hip_cooperative_groups.h>
#include <cstdio>
#include <cstdint>
namespace cg = cooperative_groups;
namespace pg8 {
#define PG8_LAS __attribute__((address_space(3)))
typedef unsigned short bf16_t;
typedef short bf16x8 __attribute__((ext_vector_type(8)));
typedef float f32x4 __attribute__((ext_vector_type(4)));
typedef unsigned u32x4 __attribute__((ext_vector_type(4)));
constexpr int BM = 256, BK = 64, HALF = 128, HTB = HALF * BK * 2  , STAGE_BYTES = 8 * HTB, NXCD = 8, WGM = 8;

__host__ __device__ __forceinline__ int lds_byte(int r, int c) { const int st = (r >> 4) * 2 + (c >> 5), rr = r & 15, cc = c & 31, ob = rr * 64 + cc * 2; return st * 1024 + (ob ^ (((ob >> 9) & 1) << 5)); }
__host__ __device__ __forceinline__ void stage_rc(int b, int& R, int& C) { const int st = b / 1024, sb = b % 1024, swz = sb ^ (((sb >> 9) & 1) << 5); R = (st >> 1) * 16 + swz / 64; C = (st & 1) * 32 + (swz % 64) / 2; }
__host__ __device__ __forceinline__ int perm32(int rho) { const int n = rho >> 4, i = rho & 15; return 8 * (i >> 2) + 4 * n + (i & 3); }

struct Unit { int pm, pn; };
struct Gemm { const bf16_t* A; const bf16_t* Bt; int M, N, K; int a_rows; };

struct StaticOrder {
    int nM, nN, nwg, G, c;
    __host__ __device__ void init(int M, int N, int G_, int c_) { nM = M / BM; nN = N / BM; nwg = nM * nN; G = G_; c = c_; }
    __host__ __device__ bool next(int i, Unit& u) const {
        const long L = (long)i * G + c; if (L >= nwg) return false;
        int wgid = (int)L; { const int q = nwg / NXCD, r = nwg % NXCD, xcd = wgid % NXCD, off = wgid / NXCD; wgid = (xcd < r ? xcd * (q + 1) : r * (q + 1) + (xcd - r) * q) + off; }
        const int nig = WGM * nN, gid = wgid / nig, fm = gid * WGM, gsz = (nM - fm) < WGM ? (nM - fm) : WGM;
        u.pm = fm + ((wgid % nig) % gsz); u.pn = (wgid % nig) / gsz; return true;
    }
    __device__ __forceinline__ void a_ready(const Unit&) const {}
    __device__ __forceinline__ void done(const Unit&) const {}
};

typedef __bf16 bf2_t __attribute__((ext_vector_type(2)));
typedef float f32x2_t __attribute__((ext_vector_type(2)));
__device__ __forceinline__ unsigned cvt_pk_bf16(float lo, float hi) { const f32x2_t v = {lo, hi}; return __builtin_bit_cast(unsigned, __builtin_convertvector(v, bf2_t)); }
struct EpiBf16S {
    static constexpr bool PERM = true, AFTER_DRAIN = false;
    bf16_t* O; int ldc;
    __device__ __forceinline__ void operator()(const f32x4 (&acc)[2][2][4][2], const Unit& u, int wr, int wc, int fr, int fq) const {
        const int row0 = u.pm * BM + wr * 64 + fr, col0 = u.pn * BM + wc * 32 + 8 * fq;
#pragma unroll
        for (int ai = 0; ai < 2; ++ai)
#pragma unroll
            for (int m = 0; m < 4; ++m) { bf16_t* rowp = O + (size_t)(row0 + ai * HALF + m * 16) * ldc + col0;
#pragma unroll
                for (int bj = 0; bj < 2; ++bj) { const f32x4 v0 = acc[ai][bj][m][0], v1 = acc[ai][bj][m][1];
                    u32x4 w; w.x = cvt_pk_bf16(v0[0], v0[1]); w.y = cvt_pk_bf16(v0[2], v0[3]); w.z = cvt_pk_bf16(v1[0], v1[1]); w.w = cvt_pk_bf16(v1[2], v1[3]);
                    *(u32x4*)(rowp + bj * HALF) = w; } }
    }
};
struct EpiRes {
    static constexpr bool PERM = false, AFTER_DRAIN = false;
    const float* res; float* out; int ldc;
    __device__ __forceinline__ void operator()(const f32x4 (&acc)[2][2][4][2], const Unit& u, int wr, int wc, int fr, int fq) const {
        const int row0 = u.pm * BM + wr * 64 + fr, col0 = u.pn * BM + wc * 32 + 4 * fq;
#pragma unroll
        for (int ai = 0; ai < 2; ++ai)
#pragma unroll
            for (int m = 0; m < 4; ++m) { const size_t off = (size_t)(row0 + ai * HALF + m * 16) * ldc + col0;
#pragma unroll
                for (int bj = 0; bj < 2; ++bj)
#pragma unroll
                    for (int n = 0; n < 2; ++n) { const f32x4 r = *(const f32x4*)(res + off + bj * HALF + n * 16); *(f32x4*)(out + off + bj * HALF + n * 16) = r + acc[ai][bj][m][n]; } }
    }
};

__device__ __forceinline__ float row_rstd(const float* slots, int row, int ncols, float eps) { const f32x4 v = *(const f32x4*)(slots + (size_t)row * 4); return rsqrtf(((v[0] + v[1]) + (v[2] + v[3])) * (1.0f / ncols) + eps); }
struct EpiIn {
    static constexpr bool PERM = true, AFTER_DRAIN = false;
    bf16_t* O; int ldc; const float* slots; int use_rs; const float* gains[4]; PG8_LAS float* xch;
    __device__ __forceinline__ void operator()(const f32x4 (&acc)[2][2][4][2], const Unit& u, int wr, int wc, int fr, int fq) const {
        const int row0 = u.pm * BM + wr * 64 + fr, col0 = u.pn * BM + wc * 32 + 8 * fq;
        const int kind = u.pn == 0 ? 0 : u.pn == 1 ? 1 : u.pn == 3 ? 2 : u.pn == 4 ? 3 : -1;
        float rs[2][4];
        { const int tix = (wr * 4 + wc) * 64 + fq * 16 + fr;
          if (tix < 256) xch[2048 + tix] = use_rs ? row_rstd(slots, u.pm * BM + tix, 1024, 1e-6f) : 1.0f;
          asm volatile("s_waitcnt lgkmcnt(0)" ::: "memory"); __builtin_amdgcn_s_barrier(); asm volatile("" ::: "memory"); }
#pragma unroll
        for (int ai = 0; ai < 2; ++ai)
#pragma unroll
            for (int m = 0; m < 4; ++m) rs[ai][m] = xch[2048 + ai * HALF + wr * 64 + m * 16 + fr];
        if (kind >= 0) {
#pragma unroll
            for (int ai = 0; ai < 2; ++ai)
#pragma unroll
                for (int m = 0; m < 4; ++m)
#pragma unroll
                    for (int bj = 0; bj < 2; ++bj) { float s = 0.f;
#pragma unroll
                        for (int n = 0; n < 2; ++n)
#pragma unroll
                            for (int e = 0; e < 4; ++e) { const float v = acc[ai][bj][m][n][e] * rs[ai][m]; s += v * v; }
                        s += __shfl_xor(s, 16); s += __shfl_xor(s, 32);
                        if (fq == 0) xch[((ai * HALF + wr * 64 + m * 16 + fr) * 2 + bj) * 4 + wc] = s; }
            asm volatile("s_waitcnt lgkmcnt(0)" ::: "memory"); __builtin_amdgcn_s_barrier(); asm volatile("" ::: "memory");
            const float* gp = (kind == 0 ? gains[0] : kind == 1 ? gains[1] : kind == 2 ? gains[2] : gains[3]) + (wc & 1) * 32 + 8 * fq; const f32x4 g0 = *(const f32x4*)gp, g1 = *(const f32x4*)(gp + 4);
            const float qs = (kind & 1) ? 1.0f : 0.125f;
#pragma unroll
            for (int ai = 0; ai < 2; ++ai)
#pragma unroll
                for (int m = 0; m < 4; ++m) { bf16_t* rowp = O + (size_t)(row0 + ai * HALF + m * 16) * ldc + col0;
#pragma unroll
                    for (int bj = 0; bj < 2; ++bj) { const PG8_LAS float* xp = xch + ((ai * HALF + wr * 64 + m * 16 + fr) * 2 + bj) * 4 + (wc & 2);
                        const float tot = xp[0] + xp[1]; const float r = rsqrtf(tot * (1.0f / 64.0f) + 1e-6f) * qs * rs[ai][m];
                        const f32x4 v0 = acc[ai][bj][m][0] * r * g0, v1 = acc[ai][bj][m][1] * r * g1;
                        u32x4 w; w.x = cvt_pk_bf16(v0[0], v0[1]); w.y = cvt_pk_bf16(v0[2], v0[3]); w.z = cvt_pk_bf16(v1[0], v1[1]); w.w = cvt_pk_bf16(v1[2], v1[3]);
                        *(u32x4*)(rowp + bj * HALF) = w; } }
        } else {
#pragma unroll
            for (int ai = 0; ai < 2; ++ai)
#pragma unroll
                for (int m = 0; m < 4; ++m) { bf16_t* rowp = O + (size_t)(row0 + ai * HALF + m * 16) * ldc + col0; const float r = rs[ai][m];
#pragma unroll
                    for (int bj = 0; bj < 2; ++bj) { const f32x4 v0 = acc[ai][bj][m][0] * r, v1 = acc[ai][bj][m][1] * r;
                        u32x4 w; w.x = cvt_pk_bf16(v0[0], v0[1]); w.y = cvt_pk_bf16(v0[2], v0[3]); w.z = cvt_pk_bf16(v1[0], v1[1]); w.w = cvt_pk_bf16(v1[2], v1[3]);
                        *(u32x4*)(rowp + bj * HALF) = w; } }
        }
    }
};
struct EpiResN {
    static constexpr bool PERM = false, AFTER_DRAIN = false;
    const float* res; float* out; int ldc; bf16_t* An; const float* gain; float* slots; PG8_LAS float* xch; int write_a;
    __device__ __forceinline__ void operator()(const f32x4 (&acc)[2][2][4][2], const Unit& u, int wr, int wc, int fr, int fq) const {
        const int row0 = u.pm * BM + wr * 64 + fr, col0 = u.pn * BM + wc * 32 + 4 * fq;
        f32x4 gv[2][2];
#pragma unroll
        for (int bj = 0; bj < 2; ++bj)
#pragma unroll
            for (int n = 0; n < 2; ++n) gv[bj][n] = write_a ? *(const f32x4*)(gain + col0 + bj * HALF + n * 16) : (f32x4){0.f, 0.f, 0.f, 0.f};
#pragma unroll
        for (int ai = 0; ai < 2; ++ai)
#pragma unroll
            for (int m = 0; m < 4; ++m) { const size_t off = (size_t)(row0 + ai * HALF + m * 16) * ldc + col0; float ss = 0.f;
#pragma unroll
                for (int bj = 0; bj < 2; ++bj)
#pragma unroll
                    for (int n = 0; n < 2; ++n) { const f32x4 x = *(const f32x4*)(res + off + bj * HALF + n * 16) + acc[ai][bj][m][n]; *(f32x4*)(out + off + bj * HALF + n * 16) = x;
                        if (write_a) { const f32x4 a = x * gv[bj][n]; uint2 w; w.x = cvt_pk_bf16(a[0], a[1]); w.y = cvt_pk_bf16(a[2], a[3]); *(uint2*)(An + off + bj * HALF + n * 16) = w;
                            ss += (x[0] * x[0] + x[1] * x[1]) + (x[2] * x[2] + x[3] * x[3]); } }
                if (write_a) { ss += __shfl_xor(ss, 16); ss += __shfl_xor(ss, 32); if (fq == 0) xch[(ai * HALF + wr * 64 + m * 16 + fr) * 4 + wc] = ss; } }
        if (write_a) {
            asm volatile("s_waitcnt lgkmcnt(0)" ::: "memory"); __builtin_amdgcn_s_barrier(); asm volatile("" ::: "memory");
            if (wc == 0 && fq == 0) {
#pragma unroll
                for (int ai = 0; ai < 2; ++ai)
#pragma unroll
                    for (int m = 0; m < 4; ++m) { const int rl = ai * HALF + wr * 64 + m * 16 + fr; const f32x4 v = *(const PG8_LAS f32x4*)(xch + rl * 4);
                        slots[(size_t)(u.pm * BM + rl) * 4 + u.pn] = (v[0] + v[1]) + (v[2] + v[3]); } }
        }
    }
};

template <bool RES_BF16, bool OUT_F32> struct EpiResB {
    static constexpr bool PERM = true, AFTER_DRAIN = false;
    const void* res; void* out; int ldc; float* slots; PG8_LAS float* xch;
    __device__ __forceinline__ void operator()(const f32x4 (&acc)[2][2][4][2], const Unit& u, int wr, int wc, int fr, int fq) const {
        const int row0 = u.pm * BM + wr * 64 + fr, col0 = u.pn * BM + wc * 32 + 8 * fq;
#pragma unroll
        for (int ai = 0; ai < 2; ++ai)
#pragma unroll
            for (int m = 0; m < 4; ++m) { const size_t off = (size_t)(row0 + ai * HALF + m * 16) * ldc + col0; float ss = 0.f;
#pragma unroll
                for (int bj = 0; bj < 2; ++bj) { const size_t o2 = off + bj * HALF; f32x4 r0, r1;
                    if constexpr (RES_BF16) { const u32x4 w = *(const u32x4*)((const bf16_t*)res + o2);
                        r0 = (f32x4){__uint_as_float(w[0] << 16), __uint_as_float(w[0] & 0xffff0000u), __uint_as_float(w[1] << 16), __uint_as_float(w[1] & 0xffff0000u)};
                        r1 = (f32x4){__uint_as_float(w[2] << 16), __uint_as_float(w[2] & 0xffff0000u), __uint_as_float(w[3] << 16), __uint_as_float(w[3] & 0xffff0000u)}; }
                    else { r0 = *(const f32x4*)((const float*)res + o2); r1 = *(const f32x4*)((const float*)res + o2 + 4); }
                    const f32x4 x0 = r0 + acc[ai][bj][m][0], x1 = r1 + acc[ai][bj][m][1];
                    if constexpr (OUT_F32) { *(f32x4*)((float*)out + o2) = x0; *(f32x4*)((float*)out + o2 + 4) = x1; }
                    else { u32x4 w; w[0] = cvt_pk_bf16(x0[0], x0[1]); w[1] = cvt_pk_bf16(x0[2], x0[3]); w[2] = cvt_pk_bf16(x1[0], x1[1]); w[3] = cvt_pk_bf16(x1[2], x1[3]); *(u32x4*)((bf16_t*)out + o2) = w;
                        ss += ((x0[0] * x0[0] + x0[1] * x0[1]) + (x0[2] * x0[2] + x0[3] * x0[3])) + ((x1[0] * x1[0] + x1[1] * x1[1]) + (x1[2] * x1[2] + x1[3] * x1[3])); } }
                if constexpr (!OUT_F32) { ss += __shfl_xor(ss, 16); ss += __shfl_xor(ss, 32); if (fq == 0) xch[(ai * HALF + wr * 64 + m * 16 + fr) * 4 + wc] = ss; } }
        if constexpr (!OUT_F32) {
            asm volatile("s_waitcnt lgkmcnt(0)" ::: "memory"); __builtin_amdgcn_s_barrier(); asm volatile("" ::: "memory");
            if (wc == 0 && fq == 0) {
#pragma unroll
                for (int ai = 0; ai < 2; ++ai)
#pragma unroll
                    for (int m = 0; m < 4; ++m) { const int rl = ai * HALF + wr * 64 + m * 16 + fr; const f32x4 v = *(const PG8_LAS f32x4*)(xch + rl * 4);
                        slots[(size_t)(u.pm * BM + rl) * 4 + u.pn] = (v[0] + v[1]) + (v[2] + v[3]); } }
        }
    }
};

__device__ __forceinline__ float dpp_ror1(float v)  { return __builtin_bit_cast(float, __builtin_amdgcn_update_dpp(0, __builtin_bit_cast(int, v), 0x121, 0xf, 0xf, false)); }
__device__ __forceinline__ float dpp_ror15(float v) { return __builtin_bit_cast(float, __builtin_amdgcn_update_dpp(0, __builtin_bit_cast(int, v), 0x12f, 0xf, 0xf, false)); }
__device__ __forceinline__ float gelu_tanh(float x) { const float u = 0.7978845608028654f * (x + 0.044715f * x * x * x); return x / (1.0f + __expf(-2.0f * u)); }
struct EpiUp {
    static constexpr bool PERM = true, AFTER_DRAIN = false;
    bf16_t* ACT; const float* cw; const float* cb; int Tg, Mtok, dff; PG8_LAS float* xg; const float* slots;
    __device__ __forceinline__ void operator()(const f32x4 (&acc_)[2][2][4][2], const Unit& u, int wr, int wc, int fr, int fq) const {
        const int jj = wc * 32 + 8 * fq, j = u.pn * 128 + jj;
        f32x4 (&acc)[2][2][4][2] = const_cast<f32x4 (&)[2][2][4][2]>(acc_);
#pragma unroll
        for (int ai = 0; ai < 2; ++ai) {
            if (fr == 0) {
#pragma unroll
                for (int n = 0; n < 2; ++n) *(PG8_LAS f32x4*)(xg + ((ai * 2 + wr) * 2 + 0) * 128 + jj + 4 * n) = acc[ai][0][0][n]; }
            if (fr == 15) {
#pragma unroll
                for (int n = 0; n < 2; ++n) *(PG8_LAS f32x4*)(xg + ((ai * 2 + wr) * 2 + 1) * 128 + jj + 4 * n) = acc[ai][0][3][n]; }
        }
        { const int tix = (wr * 4 + wc) * 64 + fq * 16 + fr, wi = tix >> 7, ci = tix & 127;
          xg[1024 + tix] = wi < 3 ? cw[wi * dff + u.pn * 128 + ci] : cb[u.pn * 128 + ci];
          if (tix < 256) { int t = a_tok0(u.pm) + tix; t = t < 0 ? 0 : (t > Mtok - 1 ? Mtok - 1 : t); xg[1536 + tix] = row_rstd(slots, t, 1024, 1e-6f); } }
        asm volatile("s_waitcnt lgkmcnt(0)" ::: "memory"); __builtin_amdgcn_s_barrier(); asm volatile("" ::: "memory");
#pragma unroll
        for (int ai = 0; ai < 2; ++ai)
#pragma unroll
            for (int m = 0; m < 4; ++m) { const float r = xg[1536 + ai * HALF + wr * 64 + m * 16 + fr];
#pragma unroll
                for (int bj = 0; bj < 2; ++bj)
#pragma unroll
                    for (int n = 0; n < 2; ++n) acc[ai][bj][m][n] *= r; }
        typedef float v2f __attribute__((ext_vector_type(2)));
        const PG8_LAS float* wl = xg + 1024;
#pragma unroll
        for (int ai = 0; ai < 2; ++ai) {
            const int sp = wr == 1 ? ((ai * 2 + 0) * 2 + 1) : (ai == 1 ? ((0 * 2 + 1) * 2 + 1) : -1);
            const int sn = wr == 0 ? ((ai * 2 + 1) * 2 + 0) : (ai == 0 ? ((1 * 2 + 0) * 2 + 0) : -1);
#pragma unroll
            for (int m = 0; m < 4; ++m) {
                const int lr = ai * HALF + wr * 64 + m * 16 + fr, t = a_tok0(u.pm) + lr, tq = t & (Tg - 1);
                const float mp = tq == 0 ? 0.f : 1.f, mn = tq == Tg - 1 ? 0.f : 1.f;
                u32x4 ov;
#pragma unroll
                for (int n = 0; n < 2; ++n) {
                    const f32x4 w0 = *(const PG8_LAS f32x4*)(wl + jj + 4 * n), w1 = *(const PG8_LAS f32x4*)(wl + 128 + jj + 4 * n), w2 = *(const PG8_LAS f32x4*)(wl + 256 + jj + 4 * n), bb = *(const PG8_LAS f32x4*)(wl + 384 + jj + 4 * n);
                    f32x4 bp = {0.f, 0.f, 0.f, 0.f}, bn = {0.f, 0.f, 0.f, 0.f};
                    if (m == 0 && sp >= 0) bp = *(const PG8_LAS f32x4*)(xg + sp * 128 + jj + 4 * n) * xg[1536 + ai * HALF + wr * 64 - 1];
                    if (m == 3 && sn >= 0) bn = *(const PG8_LAS f32x4*)(xg + sn * 128 + jj + 4 * n) * xg[1536 + ai * HALF + wr * 64 + 64];
#pragma unroll
                    for (int eh = 0; eh < 2; ++eh) { v2f gv, p, q, up;
#pragma unroll
                        for (int k = 0; k < 2; ++k) { const int e = 2 * eh + k; const float g0 = acc[ai][0][m][n][e];
                            const float pa = m > 0 ? dpp_ror1(acc[ai][0][m > 0 ? m - 1 : 0][n][e]) : bp[e];
                            const float qa = m < 3 ? dpp_ror15(acc[ai][0][m < 3 ? m + 1 : 3][n][e]) : bn[e];
                            gv[k] = g0; up[k] = acc[ai][1][m][n][e];
                            p[k] = __builtin_bit_cast(float, __builtin_amdgcn_update_dpp(__builtin_bit_cast(int, pa), __builtin_bit_cast(int, g0), 0x111, 0xf, 0xf, false));
                            q[k] = __builtin_bit_cast(float, __builtin_amdgcn_update_dpp(__builtin_bit_cast(int, qa), __builtin_bit_cast(int, g0), 0x101, 0xf, 0xf, false)); }
                        const v2f a0 = (v2f){w0[2 * eh], w0[2 * eh + 1]} * mp, a1 = (v2f){w1[2 * eh], w1[2 * eh + 1]}, a2 = (v2f){w2[2 * eh], w2[2 * eh + 1]} * mn, ab = (v2f){bb[2 * eh], bb[2 * eh + 1]};
                        const v2f x = a0 * p + (a1 * gv + (a2 * q + ab));
                        const v2f arg = x * ((x * x) * (-0.10294324f) + (-2.3022082f));
                        v2f ex; ex[0] = __builtin_amdgcn_exp2f(arg[0]); ex[1] = __builtin_amdgcn_exp2f(arg[1]);
                        const v2f dn = ex + 1.0f; v2f rc; rc[0] = __builtin_amdgcn_rcpf(dn[0]); rc[1] = __builtin_amdgcn_rcpf(dn[1]);
                        const v2f y = (x * rc) * up;
                        ov[2 * n + eh] = cvt_pk_bf16(y[0], y[1]); }
                }
                if (lr >= 1 && lr <= 254 && t < Mtok) *(u32x4*)(ACT + (size_t)t * dff + j) = ov;
            }
        }
    }
    __device__ __forceinline__ int a_tok0(int pm) const { return 254 * pm - 1; }
};

template <class Epi, class Sched, bool ALIGN_EPI = false, bool SP2 = false>
__device__ __forceinline__ void gemm_phase(PG8_LAS unsigned char* lds, const Gemm g, const Sched& S, const Epi& E, const int tid) {
    const int wid = __builtin_amdgcn_readfirstlane(tid >> 6), lane = tid & 63, wr = wid >> 2, wc = wid & 3, fr = lane & 15, fq = lane >> 4;
    const int K = g.K, nt = K / BK;
    unsigned voffA[2], voffB[2];
#pragma unroll
    for (int i = 0; i < 2; ++i) { int R, C; stage_rc(tid * 16 + i * 8192, R, C); const int Rb = Epi::PERM ? ((R & ~31) + perm32(R & 31)) : R;
        voffA[i] = (unsigned)(R * K + C) * 2u; voffB[i] = (unsigned)(Rb * K + C) * 2u; }
    const size_t kstep = (size_t)(BK * 2);
    const size_t hstep = (size_t)HALF * K * 2;
    const size_t tstep = 2 * hstep;
    const size_t tstepA = (size_t)g.a_rows * K * 2;
    const unsigned ldsw = (unsigned)wid * 1024u;
    const int aoff = lds_byte(wr * 64 + fr, fq * 8), boff = lds_byte(wc * 32 + fr, fq * 8);
#define PG8_SA(b, h) (((b) * 2 + (h)) * HTB)
#define PG8_SB(b, h) ((4 + (b) * 2 + (h)) * HTB)
#define PG8_STAGE(bufoff, gbase, voff) do { _Pragma("unroll") for (int _i = 0; _i < 2; ++_i) \
        __builtin_amdgcn_global_load_lds((const unsigned*)((const char*)(gbase) + (voff)[_i]), (PG8_LAS unsigned*)(lds + (bufoff) + ldsw + _i * 8192), 16, 0, 0); } while (0)
#define PG8_LDA(dst, b, h) do { _Pragma("unroll") for (int m = 0; m < 4; ++m) _Pragma("unroll") for (int k = 0; k < 2; ++k) dst[m][k] = *(const PG8_LAS bf16x8*)(lds + PG8_SA(b, h) + aoff + m * 2048 + k * 1024); } while (0)
#define PG8_LDB(dst, b, h) do { _Pragma("unroll") for (int n = 0; n < 2; ++n) _Pragma("unroll") for (int k = 0; k < 2; ++k) dst[n][k] = *(const PG8_LAS bf16x8*)(lds + PG8_SB(b, h) + boff + n * 2048 + k * 1024); } while (0)
#define PG8_MMA(ai, bj, At, Bt) do { __builtin_amdgcn_s_setprio(1); _Pragma("unroll") for (int m = 0; m < 4; ++m) _Pragma("unroll") for (int n = 0; n < 2; ++n) _Pragma("unroll") for (int k = 0; k < 2; ++k) \
        acc[ai][bj][m][n] = __builtin_amdgcn_mfma_f32_16x16x32_bf16(Bt[n][k], At[m][k], acc[ai][bj][m][n], 0, 0, 0); __builtin_amdgcn_s_setprio(0); } while (0)
#define PG8_WAIT_V(n) asm volatile("s_waitcnt vmcnt(" #n ")" ::: "memory")
#define PG8_WAIT_L(n) asm volatile("s_waitcnt lgkmcnt(" #n ")" ::: "memory")
#define PG8_BAR __builtin_amdgcn_s_barrier()
#define PG8_SCHED __builtin_amdgcn_sched_barrier(0)
    Unit cur, nxt; int ui = 0;
    if (!S.next(0, cur)) return;
    f32x4 acc[2][2][4][2];
#pragma unroll
    for (int a = 0; a < 2; ++a)
#pragma unroll
        for (int b = 0; b < 2; ++b)
#pragma unroll
            for (int m = 0; m < 4; ++m)
#pragma unroll
                for (int n = 0; n < 2; ++n) acc[a][b][m][n] = (f32x4){0.f, 0.f, 0.f, 0.f};
    bf16x8 At[4][2], B0[2][2], B1[2][2];
    const char* cA = (const char*)g.A + (size_t)cur.pm * tstepA; const char* cB = (const char*)g.Bt + (size_t)cur.pn * tstep;
    S.a_ready(cur);
    if constexpr (SP2) {
        PG8_STAGE(PG8_SB(0, 0), cB, voffB); PG8_STAGE(PG8_SB(0, 1), cB + hstep, voffB); PG8_STAGE(PG8_SA(0, 0), cA, voffA); PG8_STAGE(PG8_SA(0, 1), cA + hstep, voffA);
        if (wr == 1) PG8_BAR;
        PG8_WAIT_V(2); PG8_BAR;
        PG8_STAGE(PG8_SB(1, 0), cB + kstep, voffB); PG8_STAGE(PG8_SA(1, 0), cA + kstep, voffA); PG8_STAGE(PG8_SB(1, 1), cB + hstep + kstep, voffB);
        PG8_WAIT_V(6); PG8_BAR;
    } else {
        PG8_STAGE(PG8_SB(0, 0), cB, voffB); PG8_STAGE(PG8_SA(0, 0), cA, voffA); PG8_STAGE(PG8_SB(0, 1), cB + hstep, voffB); PG8_STAGE(PG8_SA(0, 1), cA + hstep, voffA);
        if (wr == 1) PG8_BAR;
        PG8_WAIT_V(4); PG8_BAR;
        PG8_STAGE(PG8_SB(1, 0), cB + kstep, voffB); PG8_STAGE(PG8_SA(1, 0), cA + kstep, voffA); PG8_STAGE(PG8_SB(1, 1), cB + hstep + kstep, voffB);
        PG8_WAIT_V(6); PG8_BAR;
    }
    for (;;) {
        const bool has_next = S.next(ui + 1, nxt);
        const char* nA = has_next ? (const char*)g.A + (size_t)nxt.pm * tstepA : cA; const char* nB = has_next ? (const char*)g.Bt + (size_t)nxt.pn * tstep : cB;
        for (int t = 0; t < nt; t += 2) {
            const bool last = (t == nt - 2);
            const char* a1 = cA + (size_t)(t + 1) * kstep;
            const char* a2 = last ? nA : cA + (size_t)(t + 2) * kstep; const char* b2 = last ? nB : cB + (size_t)(t + 2) * kstep;
            const char* a3 = a2 + kstep; const char* b3 = b2 + kstep;
            if (last && has_next) S.a_ready(nxt);
            if constexpr (SP2) {
            PG8_LDB(B0, 0, 0); PG8_LDB(B1, 0, 1); PG8_SCHED; PG8_LDA(At, 0, 0); PG8_STAGE(PG8_SA(1, 1), a1 + hstep, voffA);
            PG8_WAIT_V(8); PG8_WAIT_L(0); PG8_BAR; PG8_MMA(0, 0, At, B0); PG8_MMA(0, 1, At, B1); PG8_BAR; PG8_SCHED;
            PG8_LDA(At, 0, 1); PG8_STAGE(PG8_SB(0, 0), b2, voffB); PG8_STAGE(PG8_SB(0, 1), b2 + hstep, voffB); PG8_STAGE(PG8_SA(0, 0), a2, voffA);
            PG8_WAIT_V(8); PG8_WAIT_L(0); PG8_BAR; PG8_MMA(1, 0, At, B0); PG8_MMA(1, 1, At, B1); PG8_BAR; PG8_SCHED;
            PG8_LDB(B0, 1, 0); PG8_LDB(B1, 1, 1); PG8_SCHED; PG8_LDA(At, 1, 0); PG8_STAGE(PG8_SA(0, 1), a2 + hstep, voffA);
            PG8_WAIT_V(8); PG8_WAIT_L(0); PG8_BAR; PG8_MMA(0, 0, At, B0); PG8_MMA(0, 1, At, B1); PG8_BAR; PG8_SCHED;
            PG8_LDA(At, 1, 1); PG8_STAGE(PG8_SB(1, 0), b3, voffB); PG8_STAGE(PG8_SB(1, 1), b3 + hstep, voffB); PG8_STAGE(PG8_SA(1, 0), a3, voffA);
            PG8_WAIT_V(8); PG8_WAIT_L(0); PG8_BAR; PG8_MMA(1, 0, At, B0); PG8_MMA(1, 1, At, B1); PG8_BAR; PG8_SCHED;
            } else {
            PG8_LDB(B0, 0, 0); PG8_SCHED; PG8_LDA(At, 0, 0); PG8_STAGE(PG8_SA(1, 1), a1 + hstep, voffA);
            PG8_WAIT_L(8); PG8_BAR; PG8_WAIT_L(0); PG8_MMA(0, 0, At, B0); PG8_BAR; PG8_SCHED;
            PG8_LDB(B1, 0, 1); PG8_STAGE(PG8_SB(0, 0), b2, voffB);
            PG8_BAR; PG8_WAIT_L(0); PG8_MMA(0, 1, At, B1); PG8_BAR;
            PG8_LDA(At, 0, 1); PG8_STAGE(PG8_SA(0, 0), a2, voffA);
            PG8_BAR; PG8_WAIT_L(0); PG8_MMA(1, 0, At, B0); PG8_BAR; PG8_SCHED;
            PG8_STAGE(PG8_SB(0, 1), b2 + hstep, voffB);
            PG8_WAIT_V(6); PG8_BAR; PG8_MMA(1, 1, At, B1); PG8_BAR;
            PG8_LDB(B0, 1, 0); PG8_SCHED; PG8_LDA(At, 1, 0); PG8_STAGE(PG8_SA(0, 1), a2 + hstep, voffA);
            PG8_WAIT_L(8); PG8_BAR; PG8_WAIT_L(0); PG8_MMA(0, 0, At, B0); PG8_BAR; PG8_SCHED;
            PG8_LDB(B1, 1, 1); PG8_STAGE(PG8_SB(1, 0), b3, voffB);
            PG8_BAR; PG8_WAIT_L(0); PG8_MMA(0, 1, At, B1); PG8_BAR;
            PG8_LDA(At, 1, 1); PG8_STAGE(PG8_SA(1, 0), a3, voffA);
            PG8_BAR; PG8_WAIT_L(0); PG8_MMA(1, 0, At, B0); PG8_BAR; PG8_SCHED;
            PG8_STAGE(PG8_SB(1, 1), b3 + hstep, voffB);
            PG8_WAIT_V(6); PG8_BAR; PG8_MMA(1, 1, At, B1); PG8_BAR;
            }
        }
        if constexpr (ALIGN_EPI) { if (wr == 0) PG8_BAR; }
        if constexpr (!Epi::AFTER_DRAIN) { E(acc, cur, wr, wc, fr, fq); S.done(cur); }
        if (!has_next) break;
#pragma unroll
        for (int a = 0; a < 2; ++a)
#pragma unroll
            for (int b = 0; b < 2; ++b)
#pragma unroll
                for (int m = 0; m < 4; ++m)
#pragma unroll
                    for (int n = 0; n < 2; ++n) acc[a][b][m][n] = (f32x4){0.f, 0.f, 0.f, 0.f};
        cur = nxt; cA = nA; cB = nB; ++ui;
        if constexpr (ALIGN_EPI) { if (wr == 1) PG8_BAR; }
    }
    PG8_WAIT_V(0);
    if constexpr (!ALIGN_EPI) { if (wr == 0) PG8_BAR; }
    PG8_BAR;
    if constexpr (Epi::AFTER_DRAIN) { E.fused(acc, cur, wr, wc, fr, fq, lds, wid, lane); S.done(cur); }
#undef PG8_SA
#undef PG8_SB
#undef PG8_STAGE
#undef PG8_LDA
#undef PG8_LDB
#undef PG8_MMA
#undef PG8_WAIT_V
#undef PG8_WAIT_L
#undef PG8_BAR
#undef PG8_SCHED
}
}
#define LAS __attribute__((address_space(3)))
#define DI __device__ __forceinline__
typedef unsigned short bf16;
typedef short bf16x8 __attribute__((ext_vector_type(8)));
typedef short s16x4 __attribute__((ext_vector_type(4)));
typedef float f32x4 __attribute__((ext_vector_type(4)));
typedef unsigned u32x4 __attribute__((ext_vector_type(4)));
constexpr int NT = 512;
constexpr int LDS_BYTES = 160 * 1024;
constexpr int MG = 16384;
constexpr int DM = 1024, NIN = 4096, DFF = 2816, NUP = 5632;
constexpr int C_AQ = 0, C_AK = 256, C_AV = 512, C_BQ = 768, C_BK = 1024, C_BV = 1280, C_CQ = 1536, C_CFF = 2048, C_CFB = 2560, C_CI = 3072, C_CG = 3584;
constexpr size_t MiB = 1u << 20;
constexpr size_t WS_LB = 0, WS_WIN = 1 * MiB, WS_WOUT = 17 * MiB, WS_WUP = 21 * MiB, WS_WDOWN = 43 * MiB, WS_H = 55 * MiB, WS_PROJ = 88 * MiB, WS_ST = 216 * MiB,
                 WS_GU = 88 * MiB, WS_ADEC = 280 * MiB, WS_DAO = 281 * MiB, WS_DALSE = 305 * MiB, WS_ACT = 306 * MiB, WS_KT1 = 394 * MiB, WS_QHB = 426 * MiB, WS_ATOT = 458 * MiB, WS_QTB = 459 * MiB, WS_END = 491 * MiB;
constexpr size_t SZ_WIN = (size_t)NIN * DM * 2, SZ_WOUT = (size_t)DM * DM * 2, SZ_WUP = (size_t)NUP * DM * 2, SZ_WDOWN = (size_t)DM * DFF * 2;
constexpr float EPS = 1e-6f;
__device__ const unsigned char T5_BUCKET[3][129] = {
{11,11,11,11,11,11,11,11,11,11,11,11,11,11,11,10,10,10,10,10,10,10,10,10,10,10,10,10,10,10,10,10,10,10,10,10,10,10,9,9,9,9,9,9,9,9,9,9,9,9,8,8,8,8,8,8,8,7,6,5,4,3,2,1,0,17,18,19,20,21,22,23,24,24,24,24,24,24,24,25,25,25,25,25,25,25,25,25,25,25,25,26,26,26,26,26,26,26,26,26,26,26,26,26,26,26,26,26,26,26,26,26,26,26,27,27,27,27,27,27,27,27,27,27,27,27,27,27,27},
{13,13,13,13,13,13,13,13,13,13,13,13,13,13,13,13,13,13,13,13,13,13,13,12,12,12,12,12,12,12,12,12,12,12,12,12,12,12,12,12,12,12,11,11,11,11,11,11,11,11,11,11,10,10,10,10,10,10,9,9,9,8,8,4,0,20,24,24,25,25,25,26,26,26,26,26,26,27,27,27,27,27,27,27,27,27,27,28,28,28,28,28,28,28,28,28,28,28,28,28,28,28,28,28,28,28,29,29,29,29,29,29,29,29,29,29,29,29,29,29,29,29,29,29,29,29,29,29,29},
{15,15,15,15,15,15,15,15,15,15,15,15,15,15,15,15,15,15,15,15,15,15,15,15,15,15,15,15,15,15,14,14,14,14,14,14,14,14,14,14,14,14,14,14,14,13,13,13,13,13,13,13,13,13,12,12,12,12,12,11,11,10,10,9,0,25,26,26,27,27,28,28,28,28,28,29,29,29,29,29,29,29,29,29,30,30,30,30,30,30,30,30,30,30,30,30,30,30,30,31,31,31,31,31,31,31,31,31,31,31,31,31,31,31,31,31,31,31,31,31,31,31,31,31,31,31,31,31,31}};

struct Ctx {
    const float *xp, *xs, *ln_mix_g, *w_in, *na_q_g, *na_k_g, *na_rpb, *da_q_g, *da_k_g, *t5_bias, *hg_lb_logits, *hg_norm_g, *w_out, *ln_ffn_g, *w_up, *conv_w, *conv_b, *w_down;
    float* out; unsigned char* ws;
};

DI float bf2f(unsigned v) { return __uint_as_float(v << 16); }
DI float bflo(unsigned w) { return __uint_as_float(w << 16); }
DI float bfhi(unsigned w) { return __uint_as_float(w & 0xffff0000u); }
DI unsigned pk(float lo, float hi) { return pg8::cvt_pk_bf16(lo, hi); }
DI int clampi(int v, int lo, int hi) { return v < lo ? lo : (v > hi ? hi : v); }
DI f32x4 mfma32(bf16x8 a, bf16x8 b, f32x4 c) { return __builtin_amdgcn_mfma_f32_16x16x32_bf16(a, b, c, 0, 0, 0); }
DI f32x4 mfma16(s16x4 a, s16x4 b, f32x4 c) { return __builtin_amdgcn_mfma_f32_16x16x16bf16_1k(a, b, c, 0, 0, 0); }
DI s16x4 pack4(f32x4 v) { uint2 w; w.x = pk(v[0], v[1]); w.y = pk(v[2], v[3]); return __builtin_bit_cast(s16x4, w); }
DI bf16x8 ld_contig(const LAS bf16* img, int ld, int r0, int c0, int lane) { return *(const LAS bf16x8*)(img + (r0 + (lane & 15)) * ld + c0 + (lane >> 4) * 8); }
DI bf16x8 ld_tr8(const LAS bf16* img, int ld, int k0, int n0, int lane) {
    const int g = lane >> 4, li = lane & 15, q = li >> 2, p = li & 3;
    const LAS bf16* a = img + (k0 + g * 8 + q) * ld + n0 + 4 * p;
    const s16x4 lo = __builtin_amdgcn_ds_read_tr16_b64_v4i16((LAS s16x4*)a);
    const s16x4 hi = __builtin_amdgcn_ds_read_tr16_b64_v4i16((LAS s16x4*)(a + 4 * ld));
    return (bf16x8){lo[0], lo[1], lo[2], lo[3], hi[0], hi[1], hi[2], hi[3]};
}
DI s16x4 ld_tr4(const LAS bf16* img, int ld, int k0, int n0, int lane) {
    const int g = lane >> 4, li = lane & 15, q = li >> 2, p = li & 3;
    return __builtin_amdgcn_ds_read_tr16_b64_v4i16((LAS s16x4*)(img + (k0 + g * 4 + q) * ld + n0 + 4 * p));
}
DI void gate_fn(float z, float lb, float& lf, float& kk) {
    const float ez = __expf(-z), s = __builtin_amdgcn_rcpf(1.0f + ez);
    lf = __builtin_amdgcn_logf(lb + (1.0f - lb) * s) * 0.69314718056f;
    kk = (1.0f - lb) * (ez * s);
}
DI int fr_off(int r, int k) { return (((((r >> 4) * 4 + (k >> 5)) * 64) + ((k >> 3) & 3) * 16 + (r & 15)) << 3) + (k & 7); }
DI float silu_f(float x) { return x * __builtin_amdgcn_rcpf(1.0f + __expf(-x)); }

DI void transpose_w(const float* W, bf16* Bt, int K, int N, int mode, const float* rowgain, LAS float* tile, int bid, int nb, int tid) {
    const int tk = K / 64, tn = N / 64;
    for (int t = bid; t < tk * tn; t += nb) {
        const int k0 = (t % tk) * 64, n0 = (t / tk) * 64;
        int ns0 = n0; if (mode) { const int pn = n0 >> 8, jj = n0 & 255; ns0 = (jj < 128) ? pn * 128 + jj : DFF + pn * 128 + (jj - 128); }
#pragma unroll
        for (int it = 0; it < 8; ++it) { const int r = (tid >> 6) + 8 * it, cc = tid & 63; tile[r * 65 + cc] = W[(size_t)(k0 + r) * N + ns0 + cc] * (rowgain ? rowgain[k0 + r] : 1.0f); }
        __syncthreads();
#pragma unroll
        for (int it = 0; it < 4; ++it) { const int nn = (tid >> 5) + 16 * it, kp = tid & 31;
            *(unsigned*)(Bt + (size_t)(n0 + nn) * K + k0 + 2 * kp) = pk(tile[(2 * kp) * 65 + nn], tile[(2 * kp + 1) * 65 + nn]); }
        __syncthreads();
    }
}
DI void phase_prologue(const Ctx& c, LAS unsigned char* lds, int bid, int nb, int tid) {
    LAS float* tile = (LAS float*)lds;
    for (int l = 0; l < 2; ++l) {
        transpose_w(c.w_in + (size_t)l * DM * NIN, (bf16*)(c.ws + WS_WIN + l * SZ_WIN), DM, NIN, 0, c.ln_mix_g + l * DM, tile, bid, nb, tid);
        transpose_w(c.w_out + (size_t)l * DM * DM, (bf16*)(c.ws + WS_WOUT + l * SZ_WOUT), DM, DM, 0, nullptr, tile, bid, nb, tid);
        transpose_w(c.w_up + (size_t)l * DM * NUP, (bf16*)(c.ws + WS_WUP + l * SZ_WUP), DM, NUP, 1, c.ln_ffn_g + l * DM, tile, bid, nb, tid);
        transpose_w(c.w_down + (size_t)l * DFF * DM, (bf16*)(c.ws + WS_WDOWN + l * SZ_WDOWN), DFF, DM, 0, nullptr, tile, bid, nb, tid);
    }
    if (bid == 0) { float* LB = (float*)(c.ws + WS_LB);
        for (int i = tid; i < 1024; i += NT) { const int dir = i >> 9, ci = i & 511; const float l0 = c.hg_lb_logits[(dir * 2 + 0) * 512 + ci], l1 = c.hg_lb_logits[(dir * 2 + 1) * 512 + ci];
            LB[(dir * 2 + 0) * 512 + ci] = 0.0f; LB[(dir * 2 + 1) * 512 + ci] = 1.0f / (1.0f + expf(l0 - l1)); } }
}

DI void phase_norm(const float* x, const float* gain, bf16* H, int bid, int nb, int tid) {
    const int wave = tid >> 6, lane = tid & 63;
    for (int row = bid * 8 + wave; row < MG; row += nb * 8) {
        const float4* xr = (const float4*)(x + (size_t)row * DM); float4 v[4]; float ss = 0.f;
#pragma unroll
        for (int q = 0; q < 4; ++q) { v[q] = xr[lane + 64 * q]; ss += v[q].x * v[q].x + v[q].y * v[q].y + v[q].z * v[q].z + v[q].w * v[q].w; }
#pragma unroll
        for (int o = 32; o >= 1; o >>= 1) ss += __shfl_xor(ss, o);
        const float r = rsqrtf(ss * (1.0f / DM) + EPS);
#pragma unroll
        for (int q = 0; q < 4; ++q) { const float4 gg = ((const float4*)gain)[lane + 64 * q]; uint2 w; w.x = pk(v[q].x * r * gg.x, v[q].y * r * gg.y); w.y = pk(v[q].z * r * gg.z, v[q].w * r * gg.w);
            *(uint2*)(H + (size_t)row * DM + (lane + 64 * q) * 4) = w; }
    }
}

DI void phase_xcast(const float* x, bf16* H, float* slots, int bid, int nb, int tid) {
    const int wave = tid >> 6, lane = tid & 63;
    for (int row = bid * 8 + wave; row < MG; row += nb * 8) {
        const float4* xr = (const float4*)(x + (size_t)row * DM); float4 v[4]; float ss = 0.f;
#pragma unroll
        for (int q = 0; q < 4; ++q) { v[q] = xr[lane + 64 * q]; ss += v[q].x * v[q].x + v[q].y * v[q].y + v[q].z * v[q].z + v[q].w * v[q].w; }
#pragma unroll
        for (int o = 32; o >= 1; o >>= 1) ss += __shfl_xor(ss, o);
#pragma unroll
        for (int q = 0; q < 4; ++q) { uint2 w; w.x = pk(v[q].x, v[q].y); w.y = pk(v[q].z, v[q].w); *(uint2*)(H + (size_t)row * DM + (lane + 64 * q) * 4) = w; }
        if (lane == 0) *(float4*)(slots + (size_t)row * 4) = make_float4(ss, 0.f, 0.f, 0.f);
    }
}

DI void phase_qknorm(const Ctx& c, int l, bf16* PROJ, int bid, int nb, int tid) {
    for (int idx = bid * NT + tid; idx < MG * 128; idx += nb * NT) {
        const int sub = idx & 7, vec = (idx >> 3) & 15, tok = idx >> 7, which = vec >> 2, hh = vec & 3;
        const int col = (which == 0 ? C_AQ : which == 1 ? C_AK : which == 2 ? C_BQ : C_BK) + hh * 64 + sub * 8;
        const float* gp = (which == 0 ? c.na_q_g : which == 1 ? c.na_k_g : which == 2 ? c.da_q_g : c.da_k_g) + l * 64 + sub * 8;
        uint4* p = (uint4*)(PROJ + (size_t)tok * NIN + col); const uint4 w = *p;
        float v[8] = {bflo(w.x), bfhi(w.x), bflo(w.y), bfhi(w.y), bflo(w.z), bfhi(w.z), bflo(w.w), bfhi(w.w)};
        float ss = 0.f;
#pragma unroll
        for (int i = 0; i < 8; ++i) ss += v[i] * v[i];
        ss += __shfl_xor(ss, 1); ss += __shfl_xor(ss, 2); ss += __shfl_xor(ss, 4);
        const float r = rsqrtf(ss * (1.0f / 64.0f) + EPS) * ((which & 1) ? 1.0f : 0.125f);
        const float4 g0 = *(const float4*)gp, g1 = *(const float4*)(gp + 4);
        uint4 o; o.x = pk(v[0] * r * g0.x, v[1] * r * g0.y); o.y = pk(v[2] * r * g0.z, v[3] * r * g0.w); o.z = pk(v[4] * r * g1.x, v[5] * r * g1.y); o.w = pk(v[6] * r * g1.z, v[7] * r * g1.w);
        *p = o;
    }
}

DI void phase_na(const Ctx& c, LAS unsigned char* lds, int g, int l, const bf16* PROJ, bf16* MIX, int bid, int nb, int tid) {
    const int Tg = g < 2 ? 16384 : 4096, nseq = g < 2 ? 1 : 4, rows = Tg / 64, nunits = nseq * (rows / 2) * 4;
    LAS bf16* Vimg = (LAS bf16*)lds;
    LAS unsigned char* Kimg = lds + 576 * 72 * 2;
    LAS float* rpbs = (LAS float*)(lds + 576 * 72 * 2 + 576 * 128);
    const int w = tid >> 6, lane = tid & 63, gq = lane >> 4, li = lane & 15;
    int dcx[8];
    { const int n_ = w & 3, kb0_ = clampi(16 * n_ - 8, 0, 32), cq_ = 16 * n_ + li, c0_ = clampi(cq_ - 8, 0, 48);
#pragma unroll
      for (int i = 0; i < 8; ++i) { const int kcol = kb0_ + 16 * (i >> 2) + gq * 4 + (i & 3); const bool ok = (kcol >= c0_) && (kcol < c0_ + 16); dcx[i] = ok ? clampi(kcol - cq_, -15, 15) + 15 : 31; } }
    const bool xa = (nb & 7) == 0;
    const int xcd = xa ? (bid & 7) : 0, slot = xa ? (bid >> 3) : bid, wpx = xa ? (nb >> 3) : nb, upx = xa ? (nunits >> 3) : nunits;
    u32x4 pv[9], pkk[9];
#define NA_PREFETCH(UNIT) do { const int h_ = (UNIT) >> 7, rp_ = ((UNIT) & 127) % (rows / 2), s_ = ((UNIT) & 127) / (rows / 2), rb_ = clampi(2 * rp_ - 4, 0, rows - 8), tb_ = s_ * Tg; \
        _Pragma("unroll") for (int i_ = 0; i_ < 9; ++i_) { const int ch_ = tid + i_ * NT, key_ = ch_ >> 3, sub_ = ch_ & 7; int gr_ = rb_ + (key_ >> 6); gr_ = gr_ > rows - 1 ? rows - 1 : gr_; \
            const bf16* p_ = PROJ + (size_t)(tb_ + gr_ * 64 + (key_ & 63)) * NIN + h_ * 64 + sub_ * 8; pv[i_] = *(const u32x4*)(p_ + C_AV); pkk[i_] = *(const u32x4*)(p_ + C_AK); } } while (0)
    if (slot < upx) NA_PREFETCH(xcd * upx + slot);
    for (int iu = slot; iu < upx; iu += wpx) {
        const int unit = xcd * upx + iu;
        const int h = unit >> 7, rp = (unit & 127) % (rows / 2), s = (unit & 127) / (rows / 2);
        const int ra = 2 * rp, rbase = clampi(ra - 4, 0, rows - 8), tokbase = s * Tg;
        const int r = ra + (w >> 2), n = w & 3, r0 = clampi(r - 4, 0, rows - 8), kb0 = clampi(16 * n - 8, 0, 32);
        const int cq = 16 * n + li, c0 = clampi(cq - 8, 0, 48), qtok = tokbase + r * 64 + cq;
        const bf16* qp = PROJ + (size_t)qtok * NIN + C_AQ + h * 64 + gq * 8;
        const bf16x8 qf0 = *(const bf16x8*)qp, qf1 = *(const bf16x8*)(qp + 32);
        f32x4 sc[16];
#pragma unroll
        for (int i = 0; i < 9; ++i) { const int ch = tid + i * NT, key = ch >> 3, sub = ch & 7;
            *(LAS u32x4*)(Vimg + key * 72 + sub * 8) = pv[i]; *(LAS u32x4*)(Kimg + key * 128 + ((sub ^ (key & 7)) << 4)) = pkk[i]; }
        if (tid < 480) { const int rr_ = tid >> 5, cc_ = tid & 31; rpbs[tid] = cc_ < 31 ? c.na_rpb[(l * 4 + h) * 465 + rr_ * 31 + cc_] : -1e30f; }
        __syncthreads();
        if (iu + wpx < upx) NA_PREFETCH(xcd * upx + iu + wpx);
#pragma unroll
        for (int t = 0; t < 16; ++t) { const int rr = t >> 1, hf = t & 1, kr = r0 + rr;
            const int krw_ = (kr - rbase) * 64 + kb0 + 16 * hf + li; const LAS unsigned char* kb_ = Kimg + krw_ * 128;
            const bf16x8 ka_ = *(const LAS bf16x8*)(kb_ + ((gq ^ (krw_ & 7)) << 4)), kb2_ = *(const LAS bf16x8*)(kb_ + (((4 + gq) ^ (krw_ & 7)) << 4));
            f32x4 sv = {0.f, 0.f, 0.f, 0.f}; sv = mfma32(ka_, qf0, sv); sv = mfma32(kb2_, qf1, sv);
            const int dr = kr - r + 7;
#pragma unroll
            for (int j = 0; j < 4; ++j) sc[t][j] = sv[j] + rpbs[dr * 32 + dcx[hf * 4 + j]]; }
        float m = -3e38f;
#pragma unroll
        for (int t = 0; t < 16; ++t)
#pragma unroll
            for (int j = 0; j < 4; ++j) m = fmaxf(m, sc[t][j]);
        m = fmaxf(m, __shfl_xor(m, 16)); m = fmaxf(m, __shfl_xor(m, 32));
        float sum = 0.f;
#pragma unroll
        for (int t = 0; t < 16; ++t)
#pragma unroll
            for (int j = 0; j < 4; ++j) { const float p = __expf(sc[t][j] - m); sc[t][j] = p; sum += p; }
        sum += __shfl_xor(sum, 16); sum += __shfl_xor(sum, 32);
        f32x4 o[4];
#pragma unroll
        for (int dt = 0; dt < 4; ++dt) o[dt] = (f32x4){0.f, 0.f, 0.f, 0.f};
#pragma unroll
        for (int t = 0; t < 16; ++t) { const int rr = t >> 1, hf = t & 1, krow = (r0 + rr - rbase) * 64 + kb0 + 16 * hf; const s16x4 pb = pack4(sc[t]);
#pragma unroll
            for (int dt = 0; dt < 4; ++dt) o[dt] = mfma16(ld_tr4(Vimg, 72, krow, dt * 16, lane), pb, o[dt]); }
        const float inv = 1.0f / sum;
#pragma unroll
        for (int dt = 0; dt < 4; ++dt) { uint2 wv; wv.x = pk(o[dt][0] * inv, o[dt][1] * inv); wv.y = pk(o[dt][2] * inv, o[dt][3] * inv);
            *(uint2*)(MIX + (size_t)qtok * DM + h * 64 + dt * 16 + gq * 4) = wv; }
        __syncthreads();
    }
}
#undef NA_PREFETCH

DI void phase_da(const Ctx& c, LAS unsigned char* lds, int g, const bf16* PROJ, bf16* DAO, float* DALSE, int bid, int nb, int tid) {
    const int Tg = g < 2 ? 16384 : 4096;
    constexpr int VB = 256 * 72 * 2, BUFB = 2 * VB + 704;
    const int w = tid >> 6, lane = tid & 63, gq = lane >> 4, li = lane & 15;
    bf16x8 qf0, qf1; u32x4 vreg[4], kreg[4]; float treg = 0.f;
    int cfg, h, d, L, seq0, rho, u0;
#define DA_DECODE(UNIT) do { cfg = (UNIT) / 512; const int rem_ = (UNIT) % 512; h = rem_ >> 7; const int blk_ = rem_ & 127; d = 1 << (2 * cfg); L = Tg / d; const int nb128_ = L / 128, per_seq_ = d * nb128_; \
        const int s_ = blk_ / per_seq_, r2_ = blk_ % per_seq_; rho = r2_ / nb128_; u0 = (r2_ % nb128_) * 128; seq0 = s_ * Tg; } while (0)
#define DA_LOAD() do { \
        const bf16* qp_ = PROJ + (size_t)(seq0 + (u0 + 16 * w + li) * d + rho) * NIN + C_BQ + h * 64 + gq * 8; qf0 = *(const bf16x8*)qp_; qf1 = *(const bf16x8*)(qp_ + 32); \
        _Pragma("unroll") for (int i_ = 0; i_ < 4; ++i_) { const int ch_ = tid + i_ * NT, kl_ = ch_ >> 3, sub_ = ch_ & 7, uk_ = u0 - 64 + kl_; vreg[i_] = (u32x4){0u, 0u, 0u, 0u}; kreg[i_] = (u32x4){0u, 0u, 0u, 0u}; \
            if (uk_ >= 0 && uk_ < L) { const bf16* rp_ = PROJ + (size_t)(seq0 + uk_ * d + rho) * NIN + h * 64 + sub_ * 8; vreg[i_] = *(const u32x4*)(rp_ + C_BV); kreg[i_] = *(const u32x4*)(rp_ + C_BK); } } \
        if (tid < 176) { const int r64_ = tid - 16; treg = (r64_ >= 0 && r64_ <= 128) ? c.t5_bias[(int)T5_BUCKET[cfg][r64_ < 0 ? 0 : (r64_ > 128 ? 128 : r64_)] * 4 + h] : -1e30f; } } while (0)
#define DA_STAGE(B) do { LAS bf16* vi_ = (LAS bf16*)(lds + (B) * BUFB); \
        _Pragma("unroll") for (int i_ = 0; i_ < 4; ++i_) { const int ch_ = tid + i_ * NT, kl_ = ch_ >> 3, sub_ = ch_ & 7; *(LAS u32x4*)(vi_ + kl_ * 72 + sub_ * 8) = vreg[i_]; *(LAS u32x4*)(vi_ + 256 * 72 + kl_ * 72 + sub_ * 8) = kreg[i_]; } \
        if (tid < 176) ((LAS float*)(lds + (B) * BUFB + 2 * VB))[tid] = treg; } while (0)
    const bool xa = (nb & 7) == 0;
    const int xcd = xa ? (bid & 7) : 0, slot = xa ? (bid >> 3) : bid, wpx = xa ? (nb >> 3) : nb, UPX = xa ? 192 : 1536;
    int iu = slot, it = 0;
    if (iu < UPX) { DA_DECODE(xcd * UPX + iu); DA_LOAD(); DA_STAGE(0); }
    __syncthreads();
    for (; iu < UPX; iu += wpx, ++it) {
        const int b = it & 1;
        const LAS bf16* Vimg = (const LAS bf16*)(lds + b * BUFB); const LAS bf16* Kimg = Vimg + 256 * 72; const LAS float* tab = (const LAS float*)(lds + b * BUFB + 2 * VB);
        const int ql = 16 * w + li, qtok = seq0 + (u0 + ql) * d + rho, ccfg = cfg, ch = h, cu0 = u0, cL = L;
        f32x4 sc[9];
#pragma unroll
        for (int tt = 0; tt < 9; ++tt) { f32x4 sv = {0.f, 0.f, 0.f, 0.f}; sv = mfma32(ld_contig(Kimg, 72, (w + tt) * 16, 0, lane), qf0, sv); sv = mfma32(ld_contig(Kimg, 72, (w + tt) * 16, 32, lane), qf1, sv); sc[tt] = sv; }
        __builtin_amdgcn_sched_barrier(0);
        const bool has_next = iu + wpx < UPX;
        if (has_next) { DA_DECODE(xcd * UPX + iu + wpx); DA_LOAD(); }
        __builtin_amdgcn_sched_barrier(0);
        { const LAS float* tl = tab + 16 + gq * 4 - li;
#pragma unroll
        for (int tt = 0; tt < 9; ++tt)
#pragma unroll
            for (int j = 0; j < 4; ++j) sc[tt][j] += tl[tt * 16 + j]; }
        if (cu0 == 0 || cu0 + 128 == cL) {
#pragma unroll
            for (int tt = 0; tt < 9; ++tt)
#pragma unroll
                for (int j = 0; j < 4; ++j) { const int ukj = cu0 - 64 + (w + tt) * 16 + gq * 4 + j; sc[tt][j] = (ukj >= 0 && ukj < cL) ? sc[tt][j] : -1e30f; } }
        float m = -3e38f;
#pragma unroll
        for (int tt = 0; tt < 9; ++tt)
#pragma unroll
            for (int j = 0; j < 4; ++j) m = fmaxf(m, sc[tt][j]);
        m = fmaxf(m, __shfl_xor(m, 16)); m = fmaxf(m, __shfl_xor(m, 32));
        float sum = 0.f;
#pragma unroll
        for (int tt = 0; tt < 9; ++tt)
#pragma unroll
            for (int j = 0; j < 4; ++j) { const float p = __expf(sc[tt][j] - m); sc[tt][j] = p; sum += p; }
        sum += __shfl_xor(sum, 16); sum += __shfl_xor(sum, 32);
        f32x4 o[4];
#pragma unroll
        for (int dt = 0; dt < 4; ++dt) o[dt] = (f32x4){0.f, 0.f, 0.f, 0.f};
#pragma unroll
        for (int tt = 0; tt < 9; ++tt) { const int krow = (w + tt) * 16; const s16x4 pb = pack4(sc[tt]);
#pragma unroll
            for (int dt = 0; dt < 4; ++dt) o[dt] = mfma16(ld_tr4(Vimg, 72, krow, dt * 16, lane), pb, o[dt]); }
        const float inv = 1.0f / sum;
#pragma unroll
        for (int dt = 0; dt < 4; ++dt) { uint2 wv; wv.x = pk(o[dt][0] * inv, o[dt][1] * inv); wv.y = pk(o[dt][2] * inv, o[dt][3] * inv);
            *(uint2*)(DAO + ((size_t)ccfg * MG + qtok) * 256 + ch * 64 + dt * 16 + gq * 4) = wv; }
        if (gq == 0) DALSE[((size_t)ccfg * MG + qtok) * 4 + ch] = m + __logf(sum);
        if (has_next) DA_STAGE(b ^ 1);
        __syncthreads();
    }
#undef DA_DECODE
#undef DA_LOAD
#undef DA_STAGE
}
DI void phase_da_combine(const bf16* DAO, const float* DALSE, bf16* MIX, int bid, int nb, int tid) {
    const int stride = nb * NT;
    for (int idx0 = bid * NT + tid; idx0 < MG * 32; idx0 += 4 * stride) {
        float l0[4], l1[4], l2[4]; u32x4 a[4], b[4], cc[4]; bool ok[4];
#pragma unroll
        for (int q = 0; q < 4; ++q) { const int idx = idx0 + q * stride; ok[q] = idx < MG * 32; const int id2 = ok[q] ? idx : idx0; const int tok = id2 >> 5, sub = id2 & 31, h = sub >> 3;
            l0[q] = DALSE[((size_t)0 * MG + tok) * 4 + h]; l1[q] = DALSE[((size_t)1 * MG + tok) * 4 + h]; l2[q] = DALSE[((size_t)2 * MG + tok) * 4 + h];
            a[q] = *(const u32x4*)(DAO + ((size_t)0 * MG + tok) * 256 + sub * 8); b[q] = *(const u32x4*)(DAO + ((size_t)1 * MG + tok) * 256 + sub * 8); cc[q] = *(const u32x4*)(DAO + ((size_t)2 * MG + tok) * 256 + sub * 8); }
#pragma unroll
        for (int q = 0; q < 4; ++q) { if (!ok[q]) continue; const int idx = idx0 + q * stride, tok = idx >> 5, sub = idx & 31;
            const float m = fmaxf(l0[q], fmaxf(l1[q], l2[q])); float w0 = __expf(l0[q] - m), w1 = __expf(l1[q] - m), w2 = __expf(l2[q] - m); const float inv = __builtin_amdgcn_rcpf(w0 + w1 + w2); w0 *= inv; w1 *= inv; w2 *= inv;
            u32x4 o;
#pragma unroll
            for (int e = 0; e < 4; ++e) o[e] = pk(w0 * bflo(a[q][e]) + w1 * bflo(b[q][e]) + w2 * bflo(cc[q][e]), w0 * bfhi(a[q][e]) + w1 * bfhi(b[q][e]) + w2 * bfhi(cc[q][e]));
            *(u32x4*)(MIX + (size_t)tok * DM + 256 + sub * 8) = o; }
    }
}

DI void phase_hg1(const Ctx& c, LAS unsigned char* lds, int g, int l, const bf16* PROJ, bf16* ST, bf16* RT, float* RDEC, float* GC, bf16* KT1, bf16* QTB, int bid, int nb, int tid) {
    const int ncs = g < 2 ? 256 : 64, rps = ncs / 8;
    constexpr int HB = 2 * 64 * 136 * 2 + 4096 + 2 * 64 * 136 * 2 + 1024;
    const float* LB = (const float*)(c.ws + WS_LB);
    const int w = tid >> 6, lane = tid & 63, gq = lane >> 4, li = lane & 15, k2 = tid & 63, seg = tid >> 6;
    unsigned qq[8]; u32x4 zch[2], qch[2], vch[2];
#define HG1_LOAD(UNIT, ZCH, QCH, VCH) do { const int dir_ = (UNIT) & 1, h_ = ((UNIT) >> 1) & 3, t0_ = ((UNIT) >> 3) * 64; const int zb_ = (dir_ ? C_CFB : C_CFF) + h_ * 128, qb_ = C_CQ + h_ * 128; \
        _Pragma("unroll") for (int i_ = 0; i_ < 2; ++i_) { const int ch_ = tid + i_ * NT, row_ = ch_ >> 4, sub_ = ch_ & 15; const bf16* rp_ = PROJ + (size_t)(t0_ + row_) * NIN + sub_ * 8; \
            ZCH[i_] = *(const u32x4*)(rp_ + zb_); QCH[i_] = *(const u32x4*)(rp_ + qb_); VCH[i_] = *(const u32x4*)(rp_ + C_CI + h_ * 128); } } while (0)
#define HG1_RAW(SET, ZCH, QCH) do { LAS bf16* rz_ = (LAS bf16*)(lds + (SET) * HB + 2 * 64 * 136 * 2 + 4096); \
        _Pragma("unroll") for (int i_ = 0; i_ < 2; ++i_) { const int ch_ = tid + i_ * NT, row_ = ch_ >> 4, sub_ = ch_ & 15; *(LAS u32x4*)(rz_ + row_ * 136 + sub_ * 8) = ZCH[i_]; *(LAS u32x4*)(rz_ + 64 * 136 + row_ * 136 + sub_ * 8) = QCH[i_]; } } while (0)
#define HG1_UNIT(R, J, U) do { const int combo_ = (R) / rps, blk_ = (R) % rps, s_ = combo_ >> 3, hd_ = combo_ & 7, p_ = blk_ * 8 + (J), cs_ = (hd_ & 1) ? ncs - 1 - p_ : p_; \
        U = (((s_ * ncs + cs_) * 4 + (hd_ >> 1)) * 2) + (hd_ & 1); } while (0)
    int unit = 0;
    if (bid < 256) { HG1_UNIT(bid, 0, unit); HG1_LOAD(unit, zch, qch, vch); HG1_RAW(0, zch, qch); }
    __syncthreads();
    for (int r = bid; r < 256; r += nb) {
      f32x4 Sloc[2][4];
#pragma unroll
      for (int a = 0; a < 2; ++a)
#pragma unroll
          for (int b = 0; b < 4; ++b) Sloc[a][b] = (f32x4){0.f, 0.f, 0.f, 0.f};
      float lrun0 = 0.f, lrun1 = 0.f;
      for (int jr = 0; jr < 8; ++jr) {
        HG1_UNIT(r, jr, unit);
        LAS unsigned char* lb_ = lds + (jr & 1) * HB;
        LAS bf16* K1 = (LAS bf16*)lb_;
        LAS bf16* Vimg = K1 + 64 * 136;
        LAS float* tot = (LAS float*)(lb_ + 2 * 64 * 136 * 2);
        LAS bf16* KS = (LAS bf16*)(lb_ + 2 * 64 * 136 * 2 + 4096);
        LAS bf16* QS = KS + 64 * 136;
        LAS float* asq = (LAS float*)(lb_ + 2 * 64 * 136 * 2 + 4096 + 2 * 64 * 136 * 2);
        const int dir = unit & 1, h = (unit >> 1) & 3;
        const float lb0 = LB[(dir * 2 + l) * 512 + h * 128 + 2 * k2], lb1 = LB[(dir * 2 + l) * 512 + h * 128 + 2 * k2 + 1];
        float pf0[8], pf1[8], fv0[8], fv1[8]; float p0 = 1.f, p1 = 1.f;
#pragma unroll
        for (int e = 0; e < 8; ++e) { const int tau_ = dir ? seg * 8 + 7 - e : seg * 8 + e; const unsigned zzv = *(const LAS unsigned*)(KS + tau_ * 136 + 2 * k2); qq[e] = *(const LAS unsigned*)(QS + tau_ * 136 + 2 * k2);
            const float z0 = bflo(zzv), z1 = bfhi(zzv);
            const float ez0 = __expf(-z0), ez1 = __expf(-z1), s0 = __builtin_amdgcn_rcpf(1.0f + ez0), s1_ = __builtin_amdgcn_rcpf(1.0f + ez1);
            const float f0 = lb0 + (1.0f - lb0) * s0, f1 = lb1 + (1.0f - lb1) * s1_;
            fv0[e] = f0; fv1[e] = f1; p0 *= f0; p1 *= f1; pf0[e] = p0; pf1[e] = p1; }
        const float run0 = __builtin_amdgcn_logf(fmaxf(p0, 1e-37f)) * 0.69314718056f, run1 = __builtin_amdgcn_logf(fmaxf(p1, 1e-37f)) * 0.69314718056f;
        tot[seg * 128 + 2 * k2] = run0; tot[seg * 128 + 2 * k2 + 1] = run1;
#pragma unroll
        for (int i = 0; i < 2; ++i) { const int ch = tid + i * NT, row = ch >> 4, sub = ch & 15; *(LAS u32x4*)(Vimg + row * 136 + sub * 8) = vch[i]; }
        __syncthreads();
        u32x4 zchn[2], qchn[2], vchn[2];
        int nunit = -1; if (jr < 7) HG1_UNIT(r, jr + 1, nunit); else if (r + nb < 256) HG1_UNIT(r + nb, 0, nunit);
        if (nunit >= 0) HG1_LOAD(nunit, zchn, qchn, vchn);
        float off0 = 0.f, off1 = 0.f, total0 = 0.f, total1 = 0.f;
#pragma unroll
        for (int s2 = 0; s2 < 8; ++s2) { const float a0 = tot[s2 * 128 + 2 * k2], a1 = tot[s2 * 128 + 2 * k2 + 1]; total0 += a0; total1 += a1;
            const bool before = dir ? (s2 > seg) : (s2 < seg); off0 += before ? a0 : 0.f; off1 += before ? a1 : 0.f; }
        bf16* kt1 = KT1 + (size_t)unit * 8192; bf16* qtb = QTB + (size_t)unit * 8192;
        const float ch0 = __expf(-0.5f * total0), ch1 = __expf(-0.5f * total1);
        const float eo0 = __expf(off0), eo1 = __expf(off1), er0 = __expf(total0 - off0 - run0), er1 = __expf(total1 - off1 - run1);
        float sf0 = 1.f, sf1 = 1.f;
#pragma unroll
        for (int e = 7; e >= 0; --e) { const int tau = dir ? seg * 8 + 7 - e : seg * 8 + e;
            const float ka = (1.0f - fv0[e]) * (er0 * sf0), kb = (1.0f - fv1[e]) * (er1 * sf1), qa = silu_f(bflo(qq[e])) * (eo0 * pf0[e]), qb = silu_f(bfhi(qq[e])) * (eo1 * pf1[e]);
            sf0 *= fv0[e]; sf1 *= fv1[e];
            *(LAS unsigned*)(K1 + tau * 136 + 2 * k2) = pk(ka, kb); *(LAS unsigned*)(KS + tau * 136 + 2 * k2) = pk(ka * ch0, kb * ch1);
            *(LAS unsigned*)(QS + tau * 136 + 2 * k2) = pk(qa * ch0, qb * ch1); }
        if (seg == 0) { *(LAS f32x4*)(asq + 4 * k2) = (f32x4){__expf(total0), __expf(0.5f * total0), __expf(total1), __expf(0.5f * total1)};
            *(float2*)(GC + (size_t)unit * 128 + 2 * k2) = make_float2(__expf(0.5f * total0 + lrun0), __expf(0.5f * total1 + lrun1)); }
        lrun0 += total0; lrun1 += total1;
        __syncthreads();
#pragma unroll
        for (int i = 0; i < 4; ++i) { const int f = w * 4 + i, st = (f >> 2) & 3, ks = f & 3;
            const bf16x8 v = ld_contig(f < 16 ? KS : QS, 136, st * 16, ks * 32, lane);
            *(bf16x8*)((f < 16 ? kt1 : qtb) + ((f & 15) * 64 + lane) * 8) = v; }
        const int kt0 = (w >> 1) * 2, vt0 = (w & 1) * 4;
        f32x4 acc[2][4];
#pragma unroll
        for (int a = 0; a < 2; ++a)
#pragma unroll
            for (int b = 0; b < 4; ++b) acc[a][b] = (f32x4){0.f, 0.f, 0.f, 0.f};
#pragma unroll
        for (int ks = 0; ks < 2; ++ks) { bf16x8 af[2], bfv[4];
#pragma unroll
            for (int a = 0; a < 2; ++a) af[a] = ld_tr8(K1, 136, ks * 32, (kt0 + a) * 16, lane);
#pragma unroll
            for (int b = 0; b < 4; ++b) bfv[b] = ld_tr8(Vimg, 136, ks * 32, (vt0 + b) * 16, lane);
#pragma unroll
            for (int a = 0; a < 2; ++a)
#pragma unroll
                for (int b = 0; b < 4; ++b) acc[a][b] = mfma32(af[a], bfv[b], acc[a][b]); }
#pragma unroll
        for (int a = 0; a < 2; ++a) { const int kb_ = (kt0 + a) * 16 + gq * 4; const f32x4 as0 = *(const LAS f32x4*)(asq + 2 * kb_), as1 = *(const LAS f32x4*)(asq + 2 * kb_ + 4);
#pragma unroll
            for (int b = 0; b < 4; ++b) { const f32x4 x = Sloc[a][b]; uint2 wv; wv.x = pk(x[0] * as0[1], x[1] * as0[3]); wv.y = pk(x[2] * as1[1], x[3] * as1[3]);
                *(uint2*)(ST + (size_t)unit * 16384 + fr_off((vt0 + b) * 16 + li, kb_)) = wv;
                Sloc[a][b] = (f32x4){as0[0] * x[0] + acc[a][b][0], as0[2] * x[1] + acc[a][b][1], as1[0] * x[2] + acc[a][b][2], as1[2] * x[3] + acc[a][b][3]}; } }
        if (jr == 7) {
#pragma unroll
            for (int a = 0; a < 2; ++a)
#pragma unroll
                for (int b = 0; b < 4; ++b) { const f32x4 x = Sloc[a][b]; uint2 wv; wv.x = pk(x[0], x[1]); wv.y = pk(x[2], x[3]);
                    *(uint2*)(RT + (size_t)r * 16384 + fr_off((vt0 + b) * 16 + li, (kt0 + a) * 16 + gq * 4)) = wv; }
            if (seg == 0) *(float4*)(RDEC + (size_t)r * 256 + 4 * k2) = make_float4(__expf(lrun0), __expf(lrun1), 1.0f, 1.0f);
        }
        if (nunit >= 0) HG1_RAW((jr + 1) & 1, zchn, qchn);
        vch[0] = vchn[0]; vch[1] = vchn[1];
        __syncthreads();
      }
    }
    __syncthreads();
#undef HG1_UNIT
#undef HG1_RAW
#undef HG1_LOAD
}
DI void phase_rscan(int g, bf16* RT, const float* RDEC, int bid, int nb, int tid) {
    const int rps = g < 2 ? 32 : 8, combos = g < 2 ? 8 : 32, ntasks = combos * 8192;
    for (int task = bid * NT + tid; task < ntasks; task += nb * NT) {
        const int e = task & 8191, combo = task >> 13;
        const int k = (((e >> 8) & 3) << 5) + (((e >> 6) & 3) << 3) + ((2 * e) & 7);
        bf16* sp = RT + (size_t)(combo * rps) * 16384 + 2 * e;
        const float* ap = RDEC + (size_t)(combo * rps) * 256 + 2 * k;
        float S0 = 0.f, S1 = 0.f;
        for (int st0 = 0; st0 < rps; st0 += 8) {
            unsigned u[8]; float4 a[8];
#pragma unroll
            for (int j = 0; j < 8; ++j) { u[j] = *(const unsigned*)(sp + (size_t)j * 16384); a[j] = *(const float4*)(ap + (size_t)j * 256); }
#pragma unroll
            for (int j = 0; j < 8; ++j) { *(unsigned*)(sp + (size_t)j * 16384) = pk(S0, S1); S0 = a[j].x * S0 + bflo(u[j]); S1 = a[j].y * S1 + bfhi(u[j]); }
            sp += 8 * 16384; ap += 8 * 256;
        }
    }
}
DI void phase_scan(int g, bf16* ST, const float* ADEC, const float* ASQ, int bid, int nb, int tid) {
    const int Tg = g < 2 ? 16384 : 4096, nseq = g < 2 ? 1 : 4, ncs = Tg / 64, ntasks = nseq * 8 * 8192;
    for (int task = bid * NT + tid; task < ntasks; task += nb * NT) {
        const int e = task & 8191, hd = (task >> 13) & 7, s = task >> 16, h = hd >> 1, dir = hd & 1;
        const int k = (((e >> 8) & 3) << 5) + (((e >> 6) & 3) << 3) + ((2 * e) & 7);
        const int c0 = s * ncs + (dir ? ncs - 1 : 0);
        const long cst = dir ? -8 : 8;
        bf16* sp = ST + ((size_t)(c0 * 4 + h) * 2 + dir) * 16384 + 2 * e;
        const float* ap = ADEC + ((size_t)(c0 * 4 + h) * 2 + dir) * 256 + 2 * k;
        float S0 = 0.f, S1 = 0.f;
        for (int st0 = 0; st0 < ncs; st0 += 32) {
            unsigned u[32]; float4 a[32];
#pragma unroll
            for (int j = 0; j < 32; ++j) { u[j] = *(const unsigned*)(sp + (long)j * cst * 16384); a[j] = *(const float4*)(ap + (long)j * cst * 256); }
#pragma unroll
            for (int j = 0; j < 32; ++j) { *(unsigned*)(sp + (long)j * cst * 16384) = pk(S0 * a[j].z, S1 * a[j].w); S0 = a[j].x * S0 + bflo(u[j]); S1 = a[j].y * S1 + bfhi(u[j]); }
            sp += 32 * cst * 16384; ap += 32 * cst * 256;
        }
    }
}
DI bf16x8 scale8(bf16x8 v, const f32x4 c0, const f32x4 c1) {
    const u32x4 w = __builtin_bit_cast(u32x4, v); u32x4 o;
    o[0] = pk(bflo(w[0]) * c0[0], bfhi(w[0]) * c0[1]); o[1] = pk(bflo(w[1]) * c0[2], bfhi(w[1]) * c0[3]);
    o[2] = pk(bflo(w[2]) * c1[0], bfhi(w[2]) * c1[1]); o[3] = pk(bflo(w[3]) * c1[2], bfhi(w[3]) * c1[3]);
    return __builtin_bit_cast(bf16x8, o);
}
DI void phase_hg3(const Ctx& c, LAS unsigned char* lds, int g, int l, const bf16* PROJ, const bf16* ST, const bf16* RT, const float* GC, const bf16* KT1, const bf16* QTB, bf16* MIX, int bid, int nb, int tid) {
    const int ncs = g < 2 ? 256 : 64, rps = ncs / 8;
    const int w = tid >> 6, hh = w >> 2, tt = w & 3, lane = tid & 63, gq = lane >> 4, li = lane & 15;
    LAS bf16* Vimg = (LAS bf16*)lds + hh * 64 * 136;
    for (int unit = bid; unit < 512; unit += nb) {
        const int hp = unit & 1, cgk = unit >> 1, h = hp * 2 + hh, t0 = cgk * 64;
#pragma unroll
        for (int i = 0; i < 4; ++i) { const int ch = tid + i * NT, hv = ch >> 10, row = (ch >> 4) & 63, sub = ch & 15;
            *(LAS u32x4*)((LAS bf16*)lds + hv * 64 * 136 + row * 136 + sub * 8) = *(const u32x4*)(PROJ + (size_t)(t0 + row) * NIN + C_CI + (hp * 2 + hv) * 128 + sub * 8); }
        __syncthreads();
        f32x4 o[8];
#pragma unroll
        for (int vt = 0; vt < 8; ++vt) o[vt] = (f32x4){0.f, 0.f, 0.f, 0.f};
        for (int dir = 0; dir < 2; ++dir) {
            const size_t su = (size_t)(cgk * 4 + h) * 2 + dir;
            bf16x8 qt[4], kr[4][4], sa[2][8];
            const int nst = dir ? 4 - tt : tt + 1, st0 = dir ? tt : 0;
#pragma unroll
            for (int ks = 0; ks < 4; ++ks) qt[ks] = *(const bf16x8*)(QTB + su * 8192 + ((tt * 4 + ks) * 64 + lane) * 8);
#pragma unroll
            for (int si = 0; si < 4; ++si) { const int st = (st0 + si) & 3;
#pragma unroll
                for (int ks = 0; ks < 4; ++ks) kr[si][ks] = *(const bf16x8*)(KT1 + su * 8192 + ((st * 4 + ks) * 64 + lane) * 8); }
#pragma unroll
            for (int vt = 0; vt < 8; ++vt) sa[0][vt] = *(const bf16x8*)(ST + su * 16384 + ((vt * 4) * 64 + lane) * 8);
            __builtin_amdgcn_sched_barrier(0);
#pragma unroll
            for (int si = 0; si < 4; ++si) {
                if (si < nst) { const int st = st0 + si;
                    f32x4 acc = {0.f, 0.f, 0.f, 0.f};
#pragma unroll
                    for (int ks = 0; ks < 4; ++ks) acc = mfma32(kr[si][ks], qt[ks], acc);
#pragma unroll
                    for (int j = 0; j < 4; ++j) { const int sg = st * 16 + gq * 4 + j, ta = tt * 16 + li; const bool keep = dir ? (sg >= ta) : (sg <= ta); acc[j] = keep ? acc[j] : 0.f; }
                    const s16x4 pb = pack4(acc);
#pragma unroll
                    for (int vt = 0; vt < 8; ++vt) o[vt] = mfma16(ld_tr4(Vimg, 136, st * 16, vt * 16, lane), pb, o[vt]);
                }
            }
#pragma unroll
            for (int ks = 0; ks < 4; ++ks) {
                if (ks < 3) {
#pragma unroll
                    for (int vt = 0; vt < 8; ++vt) sa[(ks + 1) & 1][vt] = *(const bf16x8*)(ST + su * 16384 + ((vt * 4 + ks + 1) * 64 + lane) * 8); }
#pragma unroll
                for (int vt = 0; vt < 8; ++vt) o[vt] = mfma32(sa[ks & 1][vt], qt[ks], o[vt]);
            }
            { const int sq_ = cgk / ncs, cs = cgk - sq_ * ncs, p = dir ? ncs - 1 - cs : cs, blk = p >> 3;
              if (blk > 0) { const size_t rr = (size_t)((sq_ * 8 + h * 2 + dir) * rps + blk);
#pragma unroll
                for (int ks = 0; ks < 4; ++ks) { const float* gp = GC + su * 128 + ks * 32 + gq * 8; const bf16x8 q2 = scale8(qt[ks], *(const f32x4*)gp, *(const f32x4*)(gp + 4));
#pragma unroll
                    for (int vt = 0; vt < 8; ++vt) sa[0][vt] = *(const bf16x8*)(RT + rr * 16384 + ((vt * 4 + ks) * 64 + lane) * 8);
#pragma unroll
                    for (int vt = 0; vt < 8; ++vt) o[vt] = mfma32(sa[0][vt], q2, o[vt]); } } }
        }
        float ssq = 0.f;
#pragma unroll
        for (int vt = 0; vt < 8; ++vt)
#pragma unroll
            for (int j = 0; j < 4; ++j) ssq += o[vt][j] * o[vt][j];
        ssq += __shfl_xor(ssq, 16); ssq += __shfl_xor(ssq, 32);
        const float rinv = rsqrtf(ssq * (1.0f / 128.0f) + EPS);
        const int tok = t0 + tt * 16 + li;
#pragma unroll
        for (int vt = 0; vt < 8; ++vt) { const int v = vt * 16 + gq * 4; const float4 gn = *(const float4*)(c.hg_norm_g + l * 128 + v);
            const uint2 gw = *(const uint2*)(PROJ + (size_t)tok * NIN + C_CG + h * 128 + v);
            uint2 wv; wv.x = pk(o[vt][0] * rinv * gn.x * silu_f(bflo(gw.x)), o[vt][1] * rinv * gn.y * silu_f(bfhi(gw.x)));
            wv.y = pk(o[vt][2] * rinv * gn.z * silu_f(bflo(gw.y)), o[vt][3] * rinv * gn.w * silu_f(bfhi(gw.y)));
            *(uint2*)(MIX + (size_t)tok * DM + 512 + h * 128 + v) = wv; }
        __syncthreads();
    }
}

DI float gelu_t(float x) { const float u = 0.7978845608028654f * (x + 0.044715f * x * x * x); return x / (1.0f + __expf(-2.0f * u)); }
DI void phase_conv(const Ctx& c, int g, int l, const bf16* GU, bf16* ACT, int bid, int nb, int tid) {
    const int Tg = g < 2 ? 16384 : 4096;
    for (int idx = bid * NT + tid; idx < (MG / 8) * 352; idx += nb * NT) {
        const int run = idx / 352, j = (idx - run * 352) * 8, pn = j >> 7, jj = j & 127, gcol = pn * 256 + jj, tok0 = run * 8, tq = tok0 % Tg;
        const bf16* gp = GU + (size_t)tok0 * NUP + gcol;
        u32x4 gr[10], up[8];
#pragma unroll
        for (int r = 0; r < 8; ++r) { gr[r + 1] = *(const u32x4*)(gp + (size_t)r * NUP); up[r] = *(const u32x4*)(gp + (size_t)r * NUP + 128); }
        gr[0] = (u32x4){0u, 0u, 0u, 0u}; gr[9] = (u32x4){0u, 0u, 0u, 0u};
        if (tq > 0) gr[0] = *(const u32x4*)(gp - NUP);
        if (tq + 8 < Tg) gr[9] = *(const u32x4*)(gp + (size_t)8 * NUP);
        const float* cw = c.conv_w + (size_t)l * 3 * DFF + j; const float* cb = c.conv_b + (size_t)l * DFF + j;
        float w0[8], w1[8], w2[8], bb[8];
        *(float4*)&w0[0] = *(const float4*)cw; *(float4*)&w0[4] = *(const float4*)(cw + 4);
        *(float4*)&w1[0] = *(const float4*)(cw + DFF); *(float4*)&w1[4] = *(const float4*)(cw + DFF + 4);
        *(float4*)&w2[0] = *(const float4*)(cw + 2 * DFF); *(float4*)&w2[4] = *(const float4*)(cw + 2 * DFF + 4);
        *(float4*)&bb[0] = *(const float4*)cb; *(float4*)&bb[4] = *(const float4*)(cb + 4);
#pragma unroll
        for (int r = 0; r < 8; ++r) { u32x4 o;
#pragma unroll
            for (int i = 0; i < 4; ++i) {
                const float xa = w0[2 * i] * bflo(gr[r][i]) + w1[2 * i] * bflo(gr[r + 1][i]) + w2[2 * i] * bflo(gr[r + 2][i]) + bb[2 * i];
                const float xb = w0[2 * i + 1] * bfhi(gr[r][i]) + w1[2 * i + 1] * bfhi(gr[r + 1][i]) + w2[2 * i + 1] * bfhi(gr[r + 2][i]) + bb[2 * i + 1];
                o[i] = pk(gelu_t(xa) * bflo(up[r][i]), gelu_t(xb) * bfhi(up[r][i])); }
            *(u32x4*)(ACT + (size_t)(tok0 + r) * DFF + j) = o; }
    }
}

#define XB_TMO      128
#define XB_XCNT(j)  (256  + 64 * (j))
#define XB_XSUB(j)  (1280 + 64 * (j))
#define XB_XGEN(j)  (2304 + 64 * (j))
#define XB_TOP      3328
#define XB_TOPGEN   3392
#define XCD_BAR_WORDS 3456
#define XB_SPIN_CAP (1u << 18)
constexpr size_t WS_BAR = 65536, WS_SSQ1 = 131072, WS_SSQ2 = 131072 + 262144, WS_H2 = 89 * MiB;
DI unsigned xb_ld(unsigned* p)              { return __hip_atomic_load(p, __ATOMIC_RELAXED, __HIP_MEMORY_SCOPE_AGENT); }
DI unsigned xb_add(unsigned* p, unsigned v) { return __hip_atomic_fetch_add(p, v, __ATOMIC_RELAXED, __HIP_MEMORY_SCOPE_AGENT); }
DI unsigned xb_xcc_id() { return (unsigned)__builtin_amdgcn_s_getreg((3 << 11) | 20) & 0xFu; }
#define XB_SPIN(cond, bar) do { unsigned _sp = 0; while (cond) { __builtin_amdgcn_s_sleep(1); \
    if ((++_sp & 255u) == 0u) { if (xb_ld(&(bar)[XB_TMO])) break; if (_sp > XB_SPIN_CAP) { atomicAdd(&(bar)[XB_TMO], 1u); break; } } } } while (0)
struct XcdBarrier { unsigned* bar; unsigned x; volatile LAS unsigned* st; };
DI XcdBarrier xcd_barrier_post(unsigned* bar, volatile LAS unsigned* st) {
    XcdBarrier b; b.bar = bar; b.x = xb_xcc_id(); b.st = st;
    if (threadIdx.x == 0) (void)xb_add(&bar[XB_XCNT(b.x)], 1u);
    return b;
}
DI void xcd_barrier_complete(unsigned* bar, unsigned x, unsigned& nloc, unsigned& nx) {
    const unsigned G = gridDim.x * gridDim.y * gridDim.z;
    unsigned sum, cnt, mine, sp = 0u;
    for (;;) {
        sum = 0u; cnt = 0u; mine = 0u;
#pragma unroll
        for (unsigned j = 0; j < 16; ++j) { const unsigned c = xb_ld(&bar[XB_XCNT(j)]); sum += c; cnt += (c > 0u) ? 1u : 0u; mine = (j == x) ? c : mine; }
        if (sum == G) break;
        __builtin_amdgcn_s_sleep(1);
        if ((++sp & 255u) == 0u) { if (xb_ld(&bar[XB_TMO])) break; if (sp > XB_SPIN_CAP) { atomicAdd(&bar[XB_TMO], 1u); break; } }
    }
    nloc = mine > 0u ? mine : 1u; nx = cnt > 0u ? cnt : 1u;
}
DI void xcd_barrier(const XcdBarrier& b) {
    asm volatile("s_waitcnt vmcnt(0)" ::: "memory");
    __syncthreads();
    if (threadIdx.x == 0) {
        unsigned* bar = b.bar;
        __builtin_amdgcn_s_waitcnt(0);
        unsigned nloc = b.st[0], nx = b.st[1];
        if (nloc == 0u) { xcd_barrier_complete(bar, b.x, nloc, nx); b.st[0] = nloc; b.st[1] = nx; }
        const unsigned old = xb_add(&bar[XB_XSUB(b.x)], 1u);
        const unsigned gen = old / nloc;
        if (old + 1u == (gen + 1u) * nloc) {
            __builtin_amdgcn_fence(__ATOMIC_RELEASE, "agent");
            asm volatile("s_waitcnt vmcnt(0)" ::: "memory");
            const unsigned og = xb_add(&bar[XB_TOP], 1u);
            const unsigned tg = og / nx;
            if (og + 1u == (tg + 1u) * nx) xb_add(&bar[XB_TOPGEN], 1u);
            else XB_SPIN(xb_ld(&bar[XB_TOPGEN]) == tg, bar);
            __builtin_amdgcn_fence(__ATOMIC_ACQUIRE, "agent");
            xb_add(&bar[XB_XGEN(b.x)], 1u);
            asm volatile("s_waitcnt vmcnt(0)" ::: "memory");
        } else {
            XB_SPIN(xb_ld(&bar[XB_XGEN(b.x)]) == gen, bar);
            __builtin_amdgcn_fence(__ATOMIC_ACQUIRE, "agent");
            asm volatile("s_waitcnt vmcnt(0)" ::: "memory");
        }
    }
    __syncthreads();
}

template <class Epi> DI void run_gemm(LAS unsigned char* lds, const bf16* A, const bf16* Bt, int N, int K, const Epi& E, int bid, int nb, int tid, int a_rows = 256, int mrows = MG) {
    pg8::Gemm gm{A, Bt, mrows, N, K, a_rows}; pg8::StaticOrder S; S.init(mrows, N, nb, bid);
    pg8::gemm_phase<Epi, pg8::StaticOrder, true, true>((PG8_LAS unsigned char*)lds, gm, S, E, tid);
}
#define LAUNDER() asm volatile("" : "+v"(tid), "+s"(bid), "+s"(nb))
#define GSYNC() xcd_barrier(xbar)
#define CGSYNC() do { asm volatile("s_waitcnt vmcnt(0) lgkmcnt(0)" ::: "memory"); grid.sync(); } while (0)
#ifndef REP_NA
#define REP_NA 1
#endif
#ifndef REP_DA
#define REP_DA 1
#endif
#ifndef REP_HG1
#define REP_HG1 1
#endif
#ifndef REP_HG3
#define REP_HG3 1
#endif
#ifndef REP_GIN
#define REP_GIN 1
#endif
#ifndef REP_GUP
#define REP_GUP 1
#endif
#ifndef REP_CONV
#define REP_CONV 1
#endif
#ifndef REP_NORM
#define REP_NORM 1
#endif
__global__ void __launch_bounds__(NT, 2) mega_fwd(Ctx c) {
    extern __shared__ __attribute__((aligned(16))) unsigned char smem[];
    LAS unsigned char* lds = (LAS unsigned char*)smem;
    cg::grid_group grid = cg::this_grid();
    int tid = threadIdx.x, bid = blockIdx.x, nb = gridDim.x;
    unsigned char* ws = c.ws;
    bf16* H = (bf16*)(ws + WS_H); bf16* PROJ = (bf16*)(ws + WS_PROJ); bf16* ST = (bf16*)(ws + WS_ST); bf16* GU = (bf16*)(ws + WS_GU); float* ADEC = (float*)(ws + WS_QHB);
    bf16* DAO = (bf16*)(ws + WS_DAO); float* DALSE = (float*)(ws + WS_DALSE); bf16* ACT = (bf16*)(ws + WS_ACT); bf16* KT1 = (bf16*)(ws + WS_KT1); bf16* QHB = (bf16*)(ws + WS_QHB); bf16* QTB = (bf16*)(ws + WS_QTB); bf16* RT = (bf16*)(ws + WS_QHB + 4 * MiB); float* RDEC = (float*)(ws + WS_QHB + 16 * MiB); float* GC = (float*)(ws + WS_QHB + 18 * MiB); bf16* H2 = (bf16*)(ws + WS_H2); bf16* MIX = (bf16*)(ws + WS_ACT);
     float* SSQ1 = (float*)(ws + WS_SSQ1); float* SSQ2 = (float*)(ws + WS_SSQ2); float* ATOT = (float*)(ws + WS_ATOT);
    volatile LAS unsigned* xst = (volatile LAS unsigned*)(lds + LDS_BYTES - 16);
    if (tid < 4) xst[tid] = 0u;
    __syncthreads();
    const XcdBarrier xbar = xcd_barrier_post((unsigned*)(ws + WS_BAR), xst);
    LAUNDER(); phase_prologue(c, lds, bid, nb, tid);
    LAUNDER(); phase_xcast(c.xp, H, SSQ1, bid, nb, tid);
    CGSYNC();
    for (int g = 0; g < 3; ++g) {
        const float* xin = g < 2 ? c.xp + (size_t)g * MG * DM : c.xs;
        float* xo = c.out + (size_t)g * MG * DM;
        for (int l = 0; l < 2; ++l) {
            for (int rep = 0; rep < REP_GIN; ++rep) { LAUNDER(); pg8::EpiIn E{PROJ, NIN, SSQ1, 1, {c.na_q_g + l * 64, c.na_k_g + l * 64, c.da_q_g + l * 64, c.da_k_g + l * 64}, (PG8_LAS float*)(lds + 131072)};
                run_gemm(lds, H, (const bf16*)(ws + WS_WIN + l * SZ_WIN), NIN, DM, E, bid, nb, tid); }
            GSYNC();
            for (int rep = 0; rep < REP_NA; ++rep) { LAUNDER(); phase_na(c, lds, g, l, PROJ, MIX, bid, nb, tid); }
            for (int rep = 0; rep < REP_DA; ++rep) { LAUNDER(); phase_da(c, lds, g, PROJ, DAO, DALSE, bid, nb, tid); }
            for (int rep = 0; rep < REP_HG1; ++rep) { LAUNDER(); phase_hg1(c, lds, g, l, PROJ, ST, RT, RDEC, GC, KT1, QTB, bid, nb, tid); }
            GSYNC();
            LAUNDER(); phase_rscan(g, RT, RDEC, bid, nb, tid);
            GSYNC();
            for (int rep = 0; rep < REP_HG3; ++rep) { LAUNDER(); phase_hg3(c, lds, g, l, PROJ, ST, RT, GC, KT1, QTB, MIX, bid, nb, tid); }
            LAUNDER(); phase_da_combine(DAO, DALSE, MIX, bid, nb, tid);
            GSYNC();
            LAUNDER();
            if (l == 0) { pg8::EpiResB<false, false> E{xin, H2, DM, SSQ2, (PG8_LAS float*)(lds + 131072)}; run_gemm(lds, MIX, (const bf16*)(ws + WS_WOUT + l * SZ_WOUT), DM, DM, E, bid, nb, tid); }
            else        { pg8::EpiResB<true, false> E{H, H2, DM, SSQ2, (PG8_LAS float*)(lds + 131072)}; run_gemm(lds, MIX, (const bf16*)(ws + WS_WOUT + l * SZ_WOUT), DM, DM, E, bid, nb, tid); }
            GSYNC();
            for (int rep = 0; rep < REP_GUP; ++rep) { LAUNDER(); pg8::EpiUp E{ACT, c.conv_w + (size_t)l * 3 * DFF, c.conv_b + (size_t)l * DFF, g < 2 ? 16384 : 4096, MG, DFF, (PG8_LAS float*)(lds + 131072), SSQ2};
                run_gemm(lds, H2 - DM, (const bf16*)(ws + WS_WUP + l * SZ_WUP), NUP, DM, E, bid, nb, tid, 254, 65 * 256); }
            GSYNC();
            LAUNDER();
            if (l == 0) { pg8::EpiResB<true, false> E{H2, H, DM, SSQ1, (PG8_LAS float*)(lds + 131072)}; run_gemm(lds, ACT, (const bf16*)(ws + WS_WDOWN + l * SZ_WDOWN), DM, DFF, E, bid, nb, tid); }
            else        { pg8::EpiResB<true, true> E{H2, xo, DM, nullptr, (PG8_LAS float*)(lds + 131072)}; run_gemm(lds, ACT, (const bf16*)(ws + WS_WDOWN + l * SZ_WDOWN), DM, DFF, E, bid, nb, tid); }
            if (l == 1 && g < 2) { LAUNDER(); phase_xcast(g == 0 ? c.xp + (size_t)MG * DM : c.xs, H, SSQ1, bid, nb, tid); }
            if (!(l == 1 && g == 2)) GSYNC();
        }
    }
}

extern "C" void kernel_launch(void* const* d_in, const int* in_sizes, int n_in, void* d_out, int out_size, void* d_ws, size_t ws_size, hipStream_t stream) {
    static int grid_blocks = 0;
    if (!grid_blocks) {
        if (hipFuncSetAttribute((const void*)mega_fwd, hipFuncAttributeMaxDynamicSharedMemorySize, LDS_BYTES) != hipSuccess) fprintf(stderr, "kernel_launch: hipFuncSetAttribute failed\n");
        int dev = 0, cus = 0, per_cu = 0;
        (void)hipGetDevice(&dev); (void)hipDeviceGetAttribute(&cus, hipDeviceAttributeMultiprocessorCount, dev);
        (void)hipOccupancyMaxActiveBlocksPerMultiprocessor(&per_cu, mega_fwd, NT, LDS_BYTES);
        if (per_cu < 1) per_cu = 1;
        grid_blocks = cus * per_cu;
        if (ws_size < WS_END) fprintf(stderr, "kernel_launch: workspace too small: %zu < %zu\n", ws_size, (size_t)WS_END);
    }
    Ctx c{};
    c.xp = (const float*)d_in[0]; c.xs = (const float*)d_in[1]; c.ln_mix_g = (const float*)d_in[2]; c.w_in = (const float*)d_in[3]; c.na_q_g = (const float*)d_in[4]; c.na_k_g = (const float*)d_in[5];
    c.na_rpb = (const float*)d_in[6]; c.da_q_g = (const float*)d_in[7]; c.da_k_g = (const float*)d_in[8]; c.t5_bias = (const float*)d_in[9]; c.hg_lb_logits = (const float*)d_in[10]; c.hg_norm_g = (const float*)d_in[11];
    c.w_out = (const float*)d_in[12]; c.ln_ffn_g = (const float*)d_in[13]; c.w_up = (const float*)d_in[14]; c.conv_w = (const float*)d_in[15]; c.conv_b = (const float*)d_in[16]; c.w_down = (const float*)d_in[17];
    c.out = (float*)d_out; c.ws = (unsigned char*)d_ws;
    if (hipMemsetAsync((char*)d_ws + WS_BAR, 0, XCD_BAR_WORDS * 4, stream) != hipSuccess) fprintf(stderr, "kernel_launch: memset of the barrier words failed\n");
    void* args[] = {&c};
    hipError_t e = hipLaunchCooperativeKernel((const void*)mega_fwd, dim3(grid_blocks), dim3(NT), args, LDS_BYTES, stream);
    if (e != hipSuccess) fprintf(stderr, "kernel_launch: cooperative launch failed: %s (grid %d)\n", hipGetErrorString(e), grid_blocks);
}
```
